# Optimizing an MI355X kernel written in HIP

```python
import math
import jax
import jax.numpy as jnp
from jax import lax
import numpy as np

D_MODEL = 1024
BATCH = 16
SEQ = 2048
DEPTH = 1

N_HEADS_A = 8
HEAD_DIM = 64
WIDTH_A = N_HEADS_A * HEAD_DIM
KV_RANK = 128
IDX_HEADS = 8
IDX_DIM = 64
TOPK_MAX = 256
N_HEADS_B = 8
WIDTH_B = N_HEADS_B * HEAD_DIM
BLOCK_Q = 128
N_BUCKETS = 32
MAX_EXACT = N_BUCKETS // 2
MAX_DISTANCE = 128
ATTN_SCALE = HEAD_DIM ** -0.5
IDX_SCALE = (IDX_HEADS ** -0.5) * (IDX_DIM ** -0.5)
N_GROUPS = 4
EXPERTS_PER_GROUP = 8
N_EXPERTS = N_GROUPS * EXPERTS_PER_GROUP
D_EXPERT = 256
TOP_K_INNER = 2
PLE_DIM = 256
EPS = 1e-6

_COLS = [
    ("q_a", WIDTH_A),
    ("c_kv", KV_RANK),
    ("q_idx", IDX_HEADS * IDX_DIM),
    ("k_idx", IDX_DIM),
    ("w_idx", IDX_HEADS),
    ("qkv_b", 3 * WIDTH_B),
    ("gate_a", D_MODEL),
    ("gate_b", D_MODEL),
]
IN_COLS = sum(c for _, c in _COLS)

kernel_name = "hybrid_dsa_stickbreak_hmoe_block"


def _rmsnorm(x, g):
    xf = x.astype(jnp.float32)
    y = xf * lax.rsqrt(jnp.mean(xf * xf, axis=-1, keepdims=True) + EPS)
    return (y * g.astype(jnp.float32)).astype(x.dtype)


def _split_cols(proj):
    out = []
    start = 0
    for _, width in _COLS:
        out.append(proj[..., start:start + width])
        start += width
    return out


def _t5_bucket(dist):
    dist = jnp.maximum(dist, 0)
    d_f = jnp.maximum(dist, 1).astype(jnp.float32)
    large = MAX_EXACT + (jnp.log(d_f / MAX_EXACT) / math.log(MAX_DISTANCE / MAX_EXACT)
                         * (N_BUCKETS - MAX_EXACT)).astype(jnp.int32)
    large = jnp.minimum(large, N_BUCKETS - 1)
    return jnp.where(dist < MAX_EXACT, dist, large)


def _dsa_branch(q, c_kv, q_idx, k_idx, w_idx, w_uk, w_uv, rel_bias):
    b, s = q.shape[0], q.shape[1]
    n_sel = min(TOPK_MAX, s // 4)
    n_blocks = s // BLOCK_Q
    q_abs = jnp.einsum("bshd,hcd->bshc", q, w_uk)
    key_pos = jnp.arange(s, dtype=jnp.int32)
    gather = jax.vmap(lambda c, i: c[i])

    def block(i):
        start = i * BLOCK_Q
        t = start + jnp.arange(BLOCK_Q, dtype=jnp.int32)
        qa = lax.dynamic_slice_in_dim(q_abs, start, BLOCK_Q, axis=1)
        qi = lax.dynamic_slice_in_dim(q_idx, start, BLOCK_Q, axis=1)
        wi = lax.dynamic_slice_in_dim(w_idx, start, BLOCK_Q, axis=1).astype(jnp.float32)
        rel = jax.nn.relu(jnp.einsum("bqhe,bse->bqhs", qi, k_idx).astype(jnp.float32))
        score = jnp.einsum("bqhs,bqh->bqs", rel, wi)
        causal = key_pos[None, :] <= t[:, None]
        score = jnp.where(causal[None], score, -jnp.inf)
        _, idx = lax.top_k(score, n_sel)
        valid = idx <= t[None, :, None]
        c_sel = gather(c_kv, idx)
        logits = jnp.einsum("bqhc,bqkc->bhqk", qa, c_sel).astype(jnp.float32) * ATTN_SCALE
        bias = rel_bias[_t5_bucket(t[None, :, None] - idx)]
        logits = logits + jnp.transpose(bias, (0, 3, 1, 2)).astype(jnp.float32)
        logits = jnp.where(valid[:, None], logits, -jnp.inf)
        probs = jax.nn.softmax(logits, axis=-1).astype(c_sel.dtype)
        return jnp.einsum("bhqk,bqkc->bqhc", probs, c_sel)

    o = lax.map(block, jnp.arange(n_blocks, dtype=jnp.int32))
    o = jnp.moveaxis(o, 0, 1).reshape(b, s, N_HEADS_A, KV_RANK)
    return jnp.einsum("bshc,hcd->bshd", o, w_uv)


def _stick_breaking_branch(q, k, v):
    b, s = q.shape[0], q.shape[1]
    n_blocks = s // BLOCK_Q
    key_pos = jnp.arange(s, dtype=jnp.int32)

    def block(i):
        start = i * BLOCK_Q
        t = start + jnp.arange(BLOCK_Q, dtype=jnp.int32)
        qb = lax.dynamic_slice_in_dim(q, start, BLOCK_Q, axis=1)
        z = jnp.einsum("bqhd,bshd->bhqs", qb, k).astype(jnp.float32) * ATTN_SCALE
        mask = (key_pos[None, :] < t[:, None])[None, None]
        log_1m = jnp.where(mask, jax.nn.log_sigmoid(-z), 0.0)
        after = lax.cumsum(log_1m, axis=3, reverse=True) - log_1m
        log_a = jax.nn.log_sigmoid(z) + after
        a = jnp.where(mask, jnp.exp(log_a), 0.0).astype(v.dtype)
        return jnp.einsum("bhqs,bshd->bqhd", a, v)

    o = lax.map(block, jnp.arange(n_blocks, dtype=jnp.int32))
    return jnp.moveaxis(o, 0, 1).reshape(b, s, N_HEADS_B, HEAD_DIM)


def _hier_moe(h, w_r1, b_r1, w_r2, b_r2, w_gate, w_up, w_down):
    b, s, d = h.shape
    hf = h.reshape(b * s, d)
    n_tok = b * s
    g_logits = jnp.matmul(hf, w_r1).astype(jnp.float32) + b_r1.astype(jnp.float32)
    g_prob = jax.nn.softmax(g_logits, axis=-1)
    g_sel = jnp.argmax(g_logits, axis=-1)
    p_g = jnp.take_along_axis(g_prob, g_sel[:, None], axis=1)[:, 0]
    e_logits = jnp.einsum("nd,gde->nge", hf, w_r2).astype(jnp.float32) + b_r2.astype(jnp.float32)
    e_sel = jnp.take_along_axis(e_logits, g_sel[:, None, None], axis=1)[:, 0]
    top_v, top_i = lax.top_k(e_sel, TOP_K_INNER)
    w_inner = jax.nn.softmax(top_v, axis=-1)
    inner = jnp.sum(jax.nn.one_hot(top_i, EXPERTS_PER_GROUP, dtype=jnp.float32) * w_inner[..., None], axis=1)
    comb = (jax.nn.one_hot(g_sel, N_GROUPS, dtype=jnp.float32)[:, :, None]
            * inner[:, None, :] * p_g[:, None, None])
    comb = comb.reshape(n_tok, N_EXPERTS).astype(h.dtype)
    out = jnp.zeros_like(hf)
    for e in range(N_EXPERTS):
        hid = jax.nn.silu(jnp.matmul(hf, w_gate[e])) * jnp.matmul(hf, w_up[e])
        out = out + comb[:, e:e + 1] * jnp.matmul(hid, w_down[e])
    return out.reshape(b, s, d)


def setup_inputs(seed: int = 0) -> dict:
    key = jax.random.key(seed)
    ks = jax.random.split(key, 24)
    f32 = jnp.float32

    def nrm(k, shape, fan_in):
        return jax.random.normal(k, shape, f32) * (fan_in ** -0.5)

    def gain(k, shape):
        return 1.0 + 0.05 * jax.random.normal(k, shape, f32)

    return {
        "x": jax.random.normal(ks[0], (BATCH, SEQ, D_MODEL), f32),
        "p": jax.random.normal(ks[1], (DEPTH, BATCH, SEQ, PLE_DIM), f32),
        "attn_norm": gain(ks[2], (DEPTH, D_MODEL)),
        "w_in": nrm(ks[3], (DEPTH, D_MODEL, IN_COLS), D_MODEL),
        "kv_norm": gain(ks[4], (DEPTH, KV_RANK)),
        "w_uk": nrm(ks[5], (DEPTH, N_HEADS_A, KV_RANK, HEAD_DIM), KV_RANK),
        "w_uv": nrm(ks[6], (DEPTH, N_HEADS_A, KV_RANK, HEAD_DIM), KV_RANK),
        "rel_bias": 0.5 * jax.random.normal(ks[7], (N_BUCKETS, N_HEADS_A), f32),
        "w_branch_a": nrm(ks[8], (DEPTH, WIDTH_A, D_MODEL), WIDTH_A),
        "w_branch_b": nrm(ks[9], (DEPTH, WIDTH_B, D_MODEL), WIDTH_B),
        "w_out": nrm(ks[10], (DEPTH, D_MODEL, D_MODEL), D_MODEL),
        "ffn_norm": gain(ks[11], (DEPTH, D_MODEL)),
        "w_r1": nrm(ks[12], (DEPTH, D_MODEL, N_GROUPS), D_MODEL),
        "b_r1": 0.01 * jax.random.normal(ks[13], (DEPTH, N_GROUPS), f32),
        "w_r2": nrm(ks[14], (DEPTH, N_GROUPS, D_MODEL, EXPERTS_PER_GROUP), D_MODEL),
        "b_r2": 0.01 * jax.random.normal(ks[15], (DEPTH, N_GROUPS, EXPERTS_PER_GROUP), f32),
        "w_gate": nrm(ks[16], (DEPTH, N_EXPERTS, D_MODEL, D_EXPERT), D_MODEL),
        "w_up": nrm(ks[17], (DEPTH, N_EXPERTS, D_MODEL, D_EXPERT), D_MODEL),
        "w_down": nrm(ks[18], (DEPTH, N_EXPERTS, D_EXPERT, D_MODEL), D_EXPERT),
        "ple_norm": gain(ks[19], (DEPTH, D_MODEL)),
        "w_ple_gate": nrm(ks[20], (DEPTH, D_MODEL, D_MODEL), D_MODEL),
        "w_ple": nrm(ks[21], (DEPTH, PLE_DIM, D_MODEL), PLE_DIM),
        "final_norm": gain(ks[22], (D_MODEL,)),
    }


def reference(x, p, attn_norm, w_in, kv_norm, w_uk, w_uv, rel_bias, w_branch_a, w_branch_b,
              w_out, ffn_norm, w_r1, b_r1, w_r2, b_r2, w_gate, w_up, w_down,
              ple_norm, w_ple_gate, w_ple, final_norm):
    b, s, _ = x.shape
    for i in range(DEPTH):
        h = _rmsnorm(x, attn_norm[i])
        proj = jnp.matmul(h, w_in[i])
        q_a, c_kv, q_idx, k_idx, w_idx, qkv_b, gate_a, gate_b = _split_cols(proj)
        q_a = q_a.reshape(b, s, N_HEADS_A, HEAD_DIM)
        c_kv = _rmsnorm(c_kv, kv_norm[i])
        q_idx = q_idx.reshape(b, s, IDX_HEADS, IDX_DIM)
        w_idx = w_idx * IDX_SCALE
        q_b, k_b, v_b = jnp.split(qkv_b.reshape(b, s, 3, N_HEADS_B, HEAD_DIM), 3, axis=2)
        o_a = _dsa_branch(q_a, c_kv, q_idx, k_idx, w_idx, w_uk[i], w_uv[i], rel_bias)
        o_b = _stick_breaking_branch(q_b[:, :, 0], k_b[:, :, 0], v_b[:, :, 0])
        y_a = jnp.matmul(o_a.reshape(b, s, WIDTH_A), w_branch_a[i])
        y_b = jnp.matmul(o_b.reshape(b, s, WIDTH_B), w_branch_b[i])
        merged = jax.nn.sigmoid(gate_a) * y_a + jax.nn.sigmoid(gate_b) * y_b
        x = x + jnp.matmul(merged, w_out[i])
        h2 = _rmsnorm(x, ffn_norm[i])
        x = x + _hier_moe(h2, w_r1[i], b_r1[i], w_r2[i], b_r2[i], w_gate[i], w_up[i], w_down[i])
        h3 = _rmsnorm(x, ple_norm[i])
        x = x + jnp.matmul(p[i], w_ple[i]) * jax.nn.sigmoid(jnp.matmul(h3, w_ple_gate[i]))
    return _rmsnorm(x, final_norm)
```

```cpp
#include <hip/hip_runtime.h>
#include <cstdio>
#include <cstdint>

#define GAS __attribute__((address_space(1)))
#define LAS __attribute__((address_space(3)))
typedef unsigned short bf16_t;
typedef short bf16x8 __attribute__((ext_vector_type(8)));
typedef short s16x4 __attribute__((ext_vector_type(4)));
typedef float f32x4 __attribute__((ext_vector_type(4)));
typedef float f32x16 __attribute__((ext_vector_type(16)));
typedef float f32x2 __attribute__((ext_vector_type(2)));
typedef unsigned u32x4 __attribute__((ext_vector_type(4)));
typedef unsigned u32x2 __attribute__((ext_vector_type(2)));
typedef short v4i16_t __attribute__((ext_vector_type(4)));

constexpr int NB = 16, SEQ = 2048, DM = 1024, NTOK = NB * SEQ;
constexpr int LDA = 3328, LDG = 2048;
constexpr int CA_QABS = 0, CA_CKV = 1024, CA_KIDX = 1152, CA_WIDX = 1216, CA_QIDX = 1280, CA_QB = 1792, CA_KB = 2304, CA_VB = 2816;
constexpr int NPROJ = LDA + LDG;
constexpr int NEXP = 32, DEXP = 256, ECAP = NTOK;
constexpr int MAXT = NTOK * 2 / 256 + NEXP;
constexpr float EPS = 1e-6f;

constexpr size_t MiB = 1u << 20;
constexpr size_t WS_CTL = 0, CTL_ZERO_BYTES = 1 * MiB;
constexpr size_t WS_W = 1 * MiB;
constexpr size_t W_IN = WS_W;
constexpr size_t W_COMB = W_IN + (size_t)NPROJ * DM * 2;
constexpr size_t W_BB = W_COMB + 2 * MiB;
constexpr size_t W_OUT = W_BB + 1 * MiB;
constexpr size_t W_GU = W_OUT + 2 * MiB;
constexpr size_t W_DN = W_GU + 32 * MiB;
constexpr size_t W_PG = W_DN + 16 * MiB;
constexpr size_t W_PLE = W_PG + 2 * MiB;
constexpr size_t W_RHI = W_PLE + MiB / 2;
constexpr size_t W_RLO = W_RHI + 128 * 1024;
constexpr size_t W_END = W_RLO + 128 * 1024;
static_assert(W_END <= 68 * MiB, "weights region");
constexpr size_t WS_PB = 68 * MiB;
constexpr size_t WS_H = 84 * MiB;
constexpr size_t WS_A = 148 * MiB;
constexpr size_t WS_Y = WS_A + 64 * MiB;
constexpr size_t WS_G = 356 * MiB;
constexpr size_t WS_S = 484 * MiB;
constexpr size_t S_CKVN = WS_S, S_KIDX = WS_S + 8 * MiB, S_SEL = WS_S + 12 * MiB;
constexpr size_t S_PERM = WS_S, S_RS = WS_S + 4 * MiB, S_CW = WS_S + 8 * MiB, S_TOKSLOT = WS_S + 12 * MiB, S_RSTD3 = WS_S + 13 * MiB, S_PART = WS_S + 14 * MiB;
constexpr size_t WS_END = 512 * MiB;
constexpr int CW_BAR = 4096;
constexpr int CW_CNT = 16384;
constexpr int CW_PANEL = 65536;
constexpr int RING_BYTES = 131072;
constexpr int MISC_OFF = RING_BYTES;
constexpr int LDS_BYTES = 147456;
constexpr int NWAVES = 8;

#define VM_WAIT() asm volatile("s_waitcnt vmcnt(0)" ::: "memory")
#define LDS_WAIT() asm volatile("s_waitcnt lgkmcnt(0)" ::: "memory")

__device__ __forceinline__ unsigned f2bf(float f) { unsigned u = __builtin_bit_cast(unsigned, f); return (u + 0x7fffu + ((u >> 16) & 1u)) >> 16; }
__device__ __forceinline__ unsigned pk2(float lo, float hi) { return f2bf(lo) | (f2bf(hi) << 16); }
__device__ __forceinline__ float bf2f(unsigned short b) { return __builtin_bit_cast(float, ((unsigned)b) << 16); }
__device__ __forceinline__ float bflo(unsigned w) { return __builtin_bit_cast(float, w << 16); }
__device__ __forceinline__ float bfhi(unsigned w) { return __builtin_bit_cast(float, w & 0xffff0000u); }
__device__ __forceinline__ unsigned cvt_pk_bf16(float lo, float hi) { unsigned r; asm volatile("v_cvt_pk_bf16_f32 %0, %1, %2" : "=v"(r) : "v"(lo), "v"(hi)); return r; }
#define GAS __attribute__((address_space(1)))
template <class T> __device__ __forceinline__ T gld(const void* p) { return *(const GAS T*)p; }
template <class T> __device__ __forceinline__ void gst(void* p, const T& v) { *(GAS T*)p = v; }
__device__ __forceinline__ float fast_exp(float x) { return __builtin_amdgcn_exp2f(x * 1.44269504089f); }
__device__ __forceinline__ float sigmoidf_(float x) { return __builtin_amdgcn_rcpf(1.0f + fast_exp(-x)); }
__device__ __forceinline__ float wave_sum(float v) {
#pragma unroll
    for (int o = 1; o < 64; o <<= 1) v += __shfl_xor(v, o);
    return v;
}

#define XB_TMO      128
#define XB_XCNT(j)  (256  + 64 * (j))
#define XB_XSUB(j)  (1280 + 64 * (j))
#define XB_XGEN(j)  (2304 + 64 * (j))
#define XB_TOP      3328
#define XB_TOPGEN   3392
#define XCD_BAR_WORDS 3456
#define XB_SPIN_CAP (1u << 18)
__device__ __forceinline__ unsigned xb_ld(unsigned* p)              { return __hip_atomic_load(p, __ATOMIC_RELAXED, __HIP_MEMORY_SCOPE_AGENT); }
__device__ __forceinline__ unsigned xb_add(unsigned* p, unsigned v) { return __hip_atomic_fetch_add(p, v, __ATOMIC_RELAXED, __HIP_MEMORY_SCOPE_AGENT); }
__device__ __forceinline__ unsigned xb_xcc_id() { return (unsigned)__builtin_amdgcn_s_getreg((3 << 11) | 20) & 0xFu; }
#define XB_SPIN(cond, bar) do { unsigned _sp = 0; while (cond) { __builtin_amdgcn_s_sleep(1); \
    if ((++_sp & 255u) == 0u) { if (xb_ld(&(bar)[XB_TMO])) break; if (_sp > XB_SPIN_CAP) { atomicAdd(&(bar)[XB_TMO], 1u); break; } } } } while (0)
struct XcdBarrier { unsigned* bar; unsigned x; volatile LAS unsigned* st; };
__device__ __forceinline__ XcdBarrier xcd_barrier_post(unsigned* bar, volatile LAS unsigned* st) {
    XcdBarrier b; b.bar = bar; b.x = xb_xcc_id(); b.st = st;
    if (threadIdx.x == 0) (void)xb_add(&bar[XB_XCNT(b.x)], 1u);
    return b;
}
__device__ __forceinline__ void xcd_barrier_complete(unsigned* bar, unsigned x, unsigned& nloc, unsigned& nx) {
    const unsigned G = gridDim.x * gridDim.y * gridDim.z;
    unsigned sum, cnt, mine, sp = 0u;
    for (;;) {
        sum = 0u; cnt = 0u; mine = 0u;
#pragma unroll
        for (unsigned j = 0; j < 16; ++j) { const unsigned c = xb_ld(&bar[XB_XCNT(j)]); sum += c; cnt += (c > 0u) ? 1u : 0u; mine = (j == x) ? c : mine; }
        if (sum == G) break;
        __builtin_amdgcn_s_sleep(1);
        if ((++sp & 255u) == 0u) { if (xb_ld(&bar[XB_TMO])) break; if (sp > XB_SPIN_CAP) { atomicAdd(&bar[XB_TMO], 1u); break; } }
    }
    nloc = mine > 0u ? mine : 1u; nx = cnt > 0u ? cnt : 1u;
}
__device__ __forceinline__ void xcd_barrier(const XcdBarrier& b) {
    asm volatile("s_waitcnt vmcnt(0)" ::: "memory");
    __syncthreads();
    if (threadIdx.x == 0) {
        unsigned* bar = b.bar;
        __builtin_amdgcn_s_waitcnt(0);
        unsigned nloc = b.st[0], nx = b.st[1];
        if (nloc == 0u) { xcd_barrier_complete(bar, b.x, nloc, nx); b.st[0] = nloc; b.st[1] = nx; }
        const unsigned old = xb_add(&bar[XB_XSUB(b.x)], 1u);
        const unsigned gen = old / nloc;
        if (old + 1u == (gen + 1u) * nloc) {
            __builtin_amdgcn_fence(__ATOMIC_RELEASE, "agent");
            asm volatile("s_waitcnt vmcnt(0)" ::: "memory");
            const unsigned og = xb_add(&bar[XB_TOP], 1u);
            const unsigned tg = og / nx;
            if (og + 1u == (tg + 1u) * nx) xb_add(&bar[XB_TOPGEN], 1u);
            else XB_SPIN(xb_ld(&bar[XB_TOPGEN]) == tg, bar);
            __builtin_amdgcn_fence(__ATOMIC_ACQUIRE, "agent");
            xb_add(&bar[XB_XGEN(b.x)], 1u);
            asm volatile("s_waitcnt vmcnt(0)" ::: "memory");
        } else {
            XB_SPIN(xb_ld(&bar[XB_XGEN(b.x)]) == gen, bar);
            __builtin_amdgcn_fence(__ATOMIC_ACQUIRE, "agent");
            asm volatile("s_waitcnt vmcnt(0)" ::: "memory");
        }
    }
    __syncthreads();
}

namespace pg8 {
constexpr int BM = 256, BK = 64, HALF = 128, HTB = HALF * BK * 2, STAGE_BYTES = 8 * HTB, NXCD = 8;
__host__ __device__ __forceinline__ int lds_byte(int r, int c) { const int st = (r >> 4) * 2 + (c >> 5), rr = r & 15, cc = c & 31, ob = rr * 64 + cc * 2; return st * 1024 + (ob ^ (((ob >> 9) & 1) << 5)); }
__host__ __device__ __forceinline__ void stage_rc(int b, int& R, int& C) { const int st = b / 1024, sb = b % 1024, swz = sb ^ (((sb >> 9) & 1) << 5); R = (st >> 1) * 16 + swz / 64; C = (st & 1) * 32 + (swz % 64) / 2; }
__host__ __device__ __forceinline__ int perm32(int rho) { const int n = rho >> 4, i = rho & 15; return 8 * (i >> 2) + 4 * n + (i & 3); }

struct Unit { int pm, pn, pb, e, r0, ne; };
struct Gemm { const bf16_t* A; const bf16_t* Bt; int lda; int K; };

struct StaticOrder {
    int nN, nwg, G, c;
    __device__ void init(int M, int N, int G_, int c_) { nN = N / BM; nwg = (M / BM) * nN; G = G_; c = c_; }
    __device__ __forceinline__ bool next(int i, Unit& u) const {
        int L;
        if ((G & 7) == 0) { const int x = c & 7, j = c >> 3, per = G >> 3, q = nwg >> 3, r = nwg & 7; const int start = x * q + (x < r ? x : r), len = q + (x < r ? 1 : 0); const int li = j + per * i; if (li >= len) return false; L = start + li; }
        else { L = i * G + c; if (L >= nwg) return false; }
        const int nM = nwg / nN, nig = 8 * nN, gid = L / nig, fm = gid * 8, gsz = (nM - fm) < 8 ? (nM - fm) : 8;
        u.pm = fm + ((L % nig) % gsz); u.pn = (L % nig) / gsz; u.pb = u.pn; u.e = 0; u.r0 = 0; u.ne = 0; return true;
    }
    __device__ __forceinline__ int arow(const Unit& u, int r) const { return u.pm * BM + r; }
};

template <class Epi, class Sched, bool GATHER>
__device__ __forceinline__ void gemm_phase(LAS unsigned char* lds, const Gemm g, const Sched& S, const Epi& E) {
    const int tid = threadIdx.x, wid = __builtin_amdgcn_readfirstlane(tid >> 6), lane = tid & 63, wr = wid >> 2, wc = wid & 3, fr = lane & 15, fq = lane >> 4;
    const int K = g.K, nt = K / BK, lda = g.lda;
    unsigned voffA[2], voffB[2]; int RA[2], CAo[2];
#pragma unroll
    for (int i = 0; i < 2; ++i) { int R, C; stage_rc(tid * 16 + i * 8192, R, C); const int Rb = Epi::PERM ? (64 * (R >> 5) + perm32(R & 31)) : R;
        RA[i] = R; CAo[i] = C * 2; voffA[i] = (unsigned)(R * lda + C) * 2u; voffB[i] = (unsigned)(Rb * K + C) * 2u; }
    unsigned vg[2][2] = {{0u, 0u}, {0u, 0u}};
    const size_t kstep = (size_t)(BK * 2);
    const size_t hstepA = (size_t)HALF * lda * 2, tstepA = 2 * hstepA;
    const size_t hstepB = (size_t)(Epi::PERM ? 32 : HALF) * K * 2, tstepB = (size_t)BM * K * 2;
    const unsigned ldsw = (unsigned)wid * 1024u;
    const int aoff = lds_byte(wr * 64 + fr, fq * 8), boff = lds_byte(wc * 32 + fr, fq * 8);
#define PG8_SA(b, h) (((b) * 2 + (h)) * HTB)
#define PG8_SB(b, h) ((4 + (b) * 2 + (h)) * HTB)
#define PG8_STAGE(bufoff, gbase, voff) do { _Pragma("unroll") for (int _i = 0; _i < 2; ++_i) \
        __builtin_amdgcn_global_load_lds((const unsigned*)((const char*)(gbase) + (voff)[_i]), (LAS unsigned*)(lds + (bufoff) + ldsw + _i * 8192), 16, 0, 0); } while (0)
#define PG8_STAGE_A(bufoff, aptr, h) do { if constexpr (GATHER) { PG8_STAGE(bufoff, (const char*)g.A + (size_t)(aptr), vg[h]); } else { PG8_STAGE(bufoff, (const char*)(aptr) + (h) * hstepA, voffA); } } while (0)
#define PG8_LOADVG(u) do { _Pragma("unroll") for (int _h = 0; _h < 2; ++_h) _Pragma("unroll") for (int _i = 0; _i < 2; ++_i) \
        vg[_h][_i] = (unsigned)S.arow(u, _h * HALF + RA[_i]) * (unsigned)(lda * 2) + (unsigned)CAo[_i]; } while (0)
#define PG8_LDA(dst, b, h) do { _Pragma("unroll") for (int m = 0; m < 4; ++m) _Pragma("unroll") for (int k = 0; k < 2; ++k) dst[m][k] = *(const LAS bf16x8*)(lds + PG8_SA(b, h) + aoff + m * 2048 + k * 1024); } while (0)
#define PG8_LDB(dst, b, h) do { _Pragma("unroll") for (int n = 0; n < 2; ++n) _Pragma("unroll") for (int k = 0; k < 2; ++k) dst[n][k] = *(const LAS bf16x8*)(lds + PG8_SB(b, h) + boff + n * 2048 + k * 1024); } while (0)
#define PG8_MMA(ai, bj, At, Bt) do { __builtin_amdgcn_s_setprio(1); _Pragma("unroll") for (int m = 0; m < 4; ++m) _Pragma("unroll") for (int n = 0; n < 2; ++n) _Pragma("unroll") for (int k = 0; k < 2; ++k) \
        acc[ai][bj][m][n] = __builtin_amdgcn_mfma_f32_16x16x32_bf16(Bt[n][k], At[m][k], acc[ai][bj][m][n], 0, 0, 0); __builtin_amdgcn_s_setprio(0); } while (0)
#define PG8_WAIT_V(n) asm volatile("s_waitcnt vmcnt(" #n ")" ::: "memory")
#define PG8_WAIT_L(n) asm volatile("s_waitcnt lgkmcnt(" #n ")" ::: "memory")
#define PG8_BAR __builtin_amdgcn_s_barrier()
#define PG8_SCHED __builtin_amdgcn_sched_barrier(0)
    Unit cur, nxt; int ui = 0;
    if (!S.next(0, cur)) return;
    f32x4 acc[2][2][4][2];
#pragma unroll
    for (int a = 0; a < 2; ++a)
#pragma unroll
        for (int b = 0; b < 2; ++b)
#pragma unroll
            for (int m = 0; m < 4; ++m)
#pragma unroll
                for (int n = 0; n < 2; ++n) acc[a][b][m][n] = (f32x4){0.f, 0.f, 0.f, 0.f};
    bf16x8 At[4][2], B0[2][2], B1[2][2];
    size_t cA = GATHER ? (size_t)0 : (size_t)((const char*)g.A + (size_t)cur.pm * tstepA);
    const char* cB = (const char*)g.Bt + (size_t)cur.pb * tstepB;
    if constexpr (GATHER) PG8_LOADVG(cur);
    PG8_STAGE(PG8_SB(0, 0), cB, voffB); PG8_STAGE(PG8_SB(0, 1), cB + hstepB, voffB); PG8_STAGE_A(PG8_SA(0, 0), cA, 0); PG8_STAGE_A(PG8_SA(0, 1), cA, 1);
    if (wr == 1) PG8_BAR;
    PG8_WAIT_V(2); PG8_BAR;
    PG8_STAGE(PG8_SB(1, 0), cB + kstep, voffB); PG8_STAGE_A(PG8_SA(1, 0), cA + kstep, 0); PG8_STAGE(PG8_SB(1, 1), cB + hstepB + kstep, voffB);
    PG8_WAIT_V(6); PG8_BAR;
    for (;;) {
        const bool has_next = S.next(ui + 1, nxt);
        const size_t nA = has_next ? (GATHER ? (size_t)0 : (size_t)((const char*)g.A + (size_t)nxt.pm * tstepA)) : cA;
        const char* nB = has_next ? (const char*)g.Bt + (size_t)nxt.pb * tstepB : cB;
        for (int t = 0; t < nt; t += 2) {
            const bool last = (t == nt - 2);
            const size_t a1 = cA + (size_t)(t + 1) * kstep;
            const size_t a2 = last ? nA : cA + (size_t)(t + 2) * kstep; const char* b2 = last ? nB : cB + (size_t)(t + 2) * kstep;
            const size_t a3 = a2 + kstep; const char* b3 = b2 + kstep;
            PG8_LDB(B0, 0, 0); PG8_LDB(B1, 0, 1); PG8_SCHED; PG8_LDA(At, 0, 0); PG8_STAGE_A(PG8_SA(1, 1), a1, 1);
            if constexpr (GATHER) { if (last && has_next) PG8_LOADVG(nxt); }
            PG8_WAIT_V(8); PG8_WAIT_L(0); PG8_BAR; PG8_MMA(0, 0, At, B0); PG8_MMA(0, 1, At, B1); PG8_BAR; PG8_SCHED;
            PG8_LDA(At, 0, 1); PG8_STAGE(PG8_SB(0, 0), b2, voffB); PG8_STAGE(PG8_SB(0, 1), b2 + hstepB, voffB); PG8_STAGE_A(PG8_SA(0, 0), a2, 0);
            PG8_WAIT_V(8); PG8_WAIT_L(0); PG8_BAR; PG8_MMA(1, 0, At, B0); PG8_MMA(1, 1, At, B1); PG8_BAR; PG8_SCHED;
            PG8_LDB(B0, 1, 0); PG8_LDB(B1, 1, 1); PG8_SCHED; PG8_LDA(At, 1, 0); PG8_STAGE_A(PG8_SA(0, 1), a2, 1);
            PG8_WAIT_V(8); PG8_WAIT_L(0); PG8_BAR; PG8_MMA(0, 0, At, B0); PG8_MMA(0, 1, At, B1); PG8_BAR; PG8_SCHED;
            PG8_LDA(At, 1, 1); PG8_STAGE(PG8_SB(1, 0), b3, voffB); PG8_STAGE(PG8_SB(1, 1), b3 + hstepB, voffB); PG8_STAGE_A(PG8_SA(1, 0), a3, 0);
            PG8_WAIT_V(8); PG8_WAIT_L(0); PG8_BAR; PG8_MMA(1, 0, At, B0); PG8_MMA(1, 1, At, B1); PG8_BAR; PG8_SCHED;
        }
        if (wr == 0) PG8_BAR;
        E(acc, cur, wr, wc, fr, fq, lds + PG8_SA(1, 1) + ldsw);
        if (!has_next) break;
#pragma unroll
        for (int a = 0; a < 2; ++a)
#pragma unroll
            for (int b = 0; b < 2; ++b)
#pragma unroll
                for (int m = 0; m < 4; ++m)
#pragma unroll
                    for (int n = 0; n < 2; ++n) acc[a][b][m][n] = (f32x4){0.f, 0.f, 0.f, 0.f};
        cur = nxt; cA = nA; cB = nB; ++ui;
        if (wr == 1) PG8_BAR;
    }
    PG8_WAIT_V(0);
    PG8_BAR;
#undef PG8_SA
#undef PG8_SB
#undef PG8_STAGE
#undef PG8_STAGE_A
#undef PG8_LOADVG
#undef PG8_LDA
#undef PG8_LDB
#undef PG8_MMA
#undef PG8_WAIT_V
#undef PG8_WAIT_L
#undef PG8_BAR
#undef PG8_SCHED
}

#define EPI_LOOP_ROWS for (int ai = 0; ai < 2; ++ai) _Pragma("unroll") for (int m = 0; m < 4; ++m)

__device__ __forceinline__ LAS u32x4* epi_frag(LAS unsigned char* scr, int fr, int ch) { return (LAS u32x4*)(scr + (fr >> 3) * 8192 + (fr & 7) * 128 + ((ch ^ (fr >> 1)) & 7) * 16); }
__device__ __forceinline__ LAS u32x4* epi_line(LAS unsigned char* scr, int i, int lane) { const int row = 8 * i + (lane >> 3); return (LAS u32x4*)(scr + i * 8192 + (lane >> 3) * 128 + (((lane & 7) ^ (row >> 1)) & 7) * 16); }
#define EPI_PK8(v0, v1) (u32x4){cvt_pk_bf16((v0)[0], (v0)[1]), cvt_pk_bf16((v0)[2], (v0)[3]), cvt_pk_bf16((v1)[0], (v1)[1]), cvt_pk_bf16((v1)[2], (v1)[3])}
struct EpiProj {
    static constexpr bool PERM = true;
    bf16_t* A; bf16_t* G; unsigned char* KF;
    __device__ __forceinline__ void operator()(const f32x4 (&acc)[2][2][4][2], const Unit& u, int wr, int wc, int fr, int fq, LAS unsigned char* scr) const {
        asm volatile("" : "+v"(fr), "+v"(fq));
        const int lane = fq * 16 + fr;
        bf16_t* base; int ldc, colt;
        if (u.pn < 13) { base = A; ldc = LDA; colt = u.pn * BM; } else { base = G; ldc = LDG; colt = (u.pn - 13) * BM; }
        bf16_t* op = base + (size_t)(u.pm * BM + wr * 64 + (lane >> 3)) * ldc + colt + wc * 64 + 8 * (lane & 7);
        LAS u32x4* f0 = epi_frag(scr, fr, fq); LAS u32x4* f1 = epi_frag(scr, fr, 4 + fq); LAS u32x4* l0 = epi_line(scr, 0, lane); LAS u32x4* l1 = epi_line(scr, 1, lane);
        const size_t st8 = (size_t)8 * ldc;
        const bool kf = (u.pn == CA_KIDX / BM) && wc == 2;
        const int grow0 = u.pm * BM + wr * 64 + fr;
#pragma unroll
        for (int ai = 0; ai < 2; ++ai) {
#pragma unroll
            for (int m = 0; m < 4; ++m) {
                asm volatile("" : "+v"(op));
                const u32x4 w0 = EPI_PK8(acc[ai][0][m][0], acc[ai][0][m][1]), w1 = EPI_PK8(acc[ai][1][m][0], acc[ai][1][m][1]);
                *f0 = w0; *f1 = w1;
                if (kf) { const int grow = grow0 + ai * HALF + m * 16; unsigned char* kp = KF + ((size_t)((grow >> 5) * 4 + (fq >> 1)) * 64 + (fq & 1) * 32 + (grow & 31)) * 16;
                    *(u32x4*)kp = w0; *(u32x4*)(kp + 2 * 1024) = w1; }
                const u32x4 r0 = *l0, r1 = *l1;
                gst<u32x4>(op, r0); gst<u32x4>(op + st8, r1);
                op += 2 * st8; }
            op += (size_t)(HALF - 64) * ldc; }
    }
};
struct EpiBf16 {
    static constexpr bool PERM = true;
    bf16_t* O; int ldc;
    __device__ __forceinline__ void operator()(const f32x4 (&acc)[2][2][4][2], const Unit& u, int wr, int wc, int fr, int fq, LAS unsigned char* scr) const {
        asm volatile("" : "+v"(fr), "+v"(fq));
        const int lane = fq * 16 + fr;
        bf16_t* op = O + (size_t)(u.pm * BM + wr * 64 + (lane >> 3)) * ldc + u.pn * BM + wc * 64 + 8 * (lane & 7);
        LAS u32x4* f0 = epi_frag(scr, fr, fq); LAS u32x4* f1 = epi_frag(scr, fr, 4 + fq); LAS u32x4* l0 = epi_line(scr, 0, lane); LAS u32x4* l1 = epi_line(scr, 1, lane);
        const size_t st8 = (size_t)8 * ldc;
#pragma unroll
        for (int ai = 0; ai < 2; ++ai) {
#pragma unroll
            for (int m = 0; m < 4; ++m) {
                asm volatile("" : "+v"(op));
                { const f32x4 v0 = acc[ai][0][m][0], v1 = acc[ai][0][m][1]; u32x4 w; w.x = cvt_pk_bf16(v0[0], v0[1]); w.y = cvt_pk_bf16(v0[2], v0[3]); w.z = cvt_pk_bf16(v1[0], v1[1]); w.w = cvt_pk_bf16(v1[2], v1[3]); *f0 = w; }
                { const f32x4 v0 = acc[ai][1][m][0], v1 = acc[ai][1][m][1]; u32x4 w; w.x = cvt_pk_bf16(v0[0], v0[1]); w.y = cvt_pk_bf16(v0[2], v0[3]); w.z = cvt_pk_bf16(v1[0], v1[1]); w.w = cvt_pk_bf16(v1[2], v1[3]); *f1 = w; }
                const u32x4 w0 = *l0, w1 = *l1;
                gst<u32x4>(op, w0); gst<u32x4>(op + st8, w1);
                op += 2 * st8; }
            op += (size_t)(HALF - 64) * ldc; }
    }
};
template <bool ACCUM> struct EpiGate {
    static constexpr bool PERM = true;
    const bf16_t* Gt; int gcol; bf16_t* Mg;
    __device__ __forceinline__ void operator()(const f32x4 (&acc)[2][2][4][2], const Unit& u, int wr, int wc, int fr, int fq, LAS unsigned char* scr) const {
        asm volatile("" : "+v"(fr), "+v"(fq));
        const int lane = fq * 16 + fr;
        const int rowl = u.pm * BM + wr * 64 + (lane >> 3), coll = u.pn * BM + wc * 64 + 8 * (lane & 7);
        LAS u32x4* f0 = epi_frag(scr, fr, fq); LAS u32x4* f1 = epi_frag(scr, fr, 4 + fq); LAS u32x4* l0 = epi_line(scr, 0, lane); LAS u32x4* l1 = epi_line(scr, 1, lane);
#pragma unroll
        for (int ai = 0; ai < 2; ++ai) {
            u32x4 gl[4][2], pl[4][2];
#pragma unroll
            for (int m = 0; m < 4; ++m)
#pragma unroll
                for (int i = 0; i < 2; ++i) { const size_t r = (size_t)(rowl + ai * HALF + m * 16 + 8 * i);
                    gl[m][i] = *(const u32x4*)(Gt + r * LDG + gcol + coll);
                    if (ACCUM) pl[m][i] = *(const u32x4*)(Mg + r * DM + coll); }
            asm volatile("s_waitcnt vmcnt(0)" ::: "memory");
#pragma unroll
            for (int m = 0; m < 4; ++m) {
                *l0 = gl[m][0]; *l1 = gl[m][1];
                const u32x4 gq[2] = {*f0, *f1};
                u32x4 pq[2];
                if (ACCUM) { *l0 = pl[m][0]; *l1 = pl[m][1]; pq[0] = *f0; pq[1] = *f1; }
                u32x4 wq[2];
#pragma unroll
                for (int bj = 0; bj < 2; ++bj) { const f32x4 v0 = acc[ai][bj][m][0], v1 = acc[ai][bj][m][1]; const u32x4 g = gq[bj];
                    float o[8];
                    o[0] = sigmoidf_(bflo(g.x)) * v0[0]; o[1] = sigmoidf_(bfhi(g.x)) * v0[1]; o[2] = sigmoidf_(bflo(g.y)) * v0[2]; o[3] = sigmoidf_(bfhi(g.y)) * v0[3];
                    o[4] = sigmoidf_(bflo(g.z)) * v1[0]; o[5] = sigmoidf_(bfhi(g.z)) * v1[1]; o[6] = sigmoidf_(bflo(g.w)) * v1[2]; o[7] = sigmoidf_(bfhi(g.w)) * v1[3];
                    if (ACCUM) { const u32x4 p = pq[bj];
                        o[0] += bflo(p.x); o[1] += bfhi(p.x); o[2] += bflo(p.y); o[3] += bfhi(p.y); o[4] += bflo(p.z); o[5] += bfhi(p.z); o[6] += bflo(p.w); o[7] += bfhi(p.w); }
                    wq[bj].x = cvt_pk_bf16(o[0], o[1]); wq[bj].y = cvt_pk_bf16(o[2], o[3]); wq[bj].z = cvt_pk_bf16(o[4], o[5]); wq[bj].w = cvt_pk_bf16(o[6], o[7]); }
                *f0 = wq[0]; *f1 = wq[1];
                const u32x4 r0 = *l0, r1 = *l1;
                bf16_t* op = Mg + (size_t)(rowl + ai * HALF + m * 16) * DM + coll;
                *(u32x4*)op = r0; *(u32x4*)(op + 8 * DM) = r1; }
        }
    }
};
struct EpiResid {
    static constexpr bool PERM = true;
    const float* X; bf16_t* X1b;
    __device__ __forceinline__ void operator()(const f32x4 (&acc)[2][2][4][2], const Unit& u, int wr, int wc, int fr, int fq, LAS unsigned char* scr) const {
        asm volatile("" : "+v"(fr), "+v"(fq));
        const int lane = fq * 16 + fr;
        const int rowl = u.pm * BM + wr * 64 + (lane >> 3);
        const int colx = u.pn * BM + wc * 64 + 4 * (lane & 7);
        const int coll = u.pn * BM + wc * 64 + 8 * (lane & 7);
        LAS u32x4* f0 = epi_frag(scr, fr, fq); LAS u32x4* f1 = epi_frag(scr, fr, 4 + fq); LAS u32x4* l0 = epi_line(scr, 0, lane); LAS u32x4* l1 = epi_line(scr, 1, lane);
        LAS f32x4* c0 = (LAS f32x4*)epi_frag(scr, fr, 2 * fq); LAS f32x4* c1 = (LAS f32x4*)epi_frag(scr, fr, 2 * fq + 1);
#pragma unroll
        for (int ai = 0; ai < 2; ++ai) {
            f32x4 xl[4][2][2];
#pragma unroll
            for (int m = 0; m < 4; ++m)
#pragma unroll
                for (int bj = 0; bj < 2; ++bj)
#pragma unroll
                    for (int i = 0; i < 2; ++i) xl[m][bj][i] = *(const f32x4*)(X + (size_t)(rowl + ai * HALF + m * 16 + 8 * i) * DM + colx + bj * 32);
            asm volatile("s_waitcnt vmcnt(0)" ::: "memory");
#pragma unroll
            for (int m = 0; m < 4; ++m) {
                u32x4 wq[2];
#pragma unroll
                for (int bj = 0; bj < 2; ++bj) { *(LAS f32x4*)l0 = xl[m][bj][0]; *(LAS f32x4*)l1 = xl[m][bj][1];
                    const f32x4 v0 = acc[ai][bj][m][0] + *c0, v1 = acc[ai][bj][m][1] + *c1;
                    wq[bj] = EPI_PK8(v0, v1); }
                *f0 = wq[0]; *f1 = wq[1];
                const u32x4 r0 = *l0, r1 = *l1;
                bf16_t* op = X1b + (size_t)(rowl + ai * HALF + m * 16) * DM + coll;
                *(u32x4*)op = r0; *(u32x4*)(op + 8 * DM) = r1; }
        }
    }
};
struct EpiMoeUp {
    static constexpr bool PERM = true;
    const float* RS; const float* CW; bf16_t* Act;
    __device__ __forceinline__ void operator()(const f32x4 (&acc)[2][2][4][2], const Unit& u, int wr, int wc, int fr, int fq, LAS unsigned char* scr) const {
        const int rl0 = wr * 64 + fr, colh = (u.pn * BM + wc * 64 + 8 * fq) >> 1;
        float rsv[2][4], cwv[2][4];
#pragma unroll
        EPI_LOOP_ROWS { const int rl = rl0 + ai * HALF + m * 16; const int pos = u.r0 + rl; const size_t si = (size_t)u.e * ECAP + (pos < ECAP ? pos : 0); rsv[ai][m] = RS[si]; cwv[ai][m] = CW[si]; }
        asm volatile("s_waitcnt vmcnt(0)" ::: "memory");
#pragma unroll
        EPI_LOOP_ROWS { const int rl = rl0 + ai * HALF + m * 16; const float rs = rsv[ai][m], cw = cwv[ai][m];
            bf16_t* rowp = Act + (size_t)(u.pm * BM + rl) * DEXP + colh;
#pragma unroll
            for (int bj = 0; bj < 2; ++bj) { const f32x4 gv = acc[ai][bj][m][0] * rs, uv = acc[ai][bj][m][1] * rs; float o[4];
#pragma unroll
                for (int j = 0; j < 4; ++j) o[j] = gv[j] * sigmoidf_(gv[j]) * uv[j] * cw;
                u32x2 w; w.x = cvt_pk_bf16(o[0], o[1]); w.y = cvt_pk_bf16(o[2], o[3]); *(u32x2*)(rowp + bj * 16) = w; } }
    }
};
struct EpiPle {
    static constexpr bool PERM = false;
    float* XO; const bf16_t* X2b; const bf16_t* T1; const float* RS3;
    __device__ __forceinline__ void operator()(const f32x4 (&acc)[2][2][4][2], const Unit& u, int wr, int wc, int fr, int fq, LAS unsigned char* scr) const {
        const int row0 = u.pm * BM + wr * 64 + fr, col0 = u.pn * BM + wc * 32 + 4 * fq;
#pragma unroll
        EPI_LOOP_ROWS { const int r = row0 + ai * HALF + m * 16; const float rs = RS3[r]; const size_t off = (size_t)r * DM + col0;
#pragma unroll
            for (int bj = 0; bj < 2; ++bj)
#pragma unroll
                for (int n = 0; n < 2; ++n) { const size_t o2 = off + bj * HALF + n * 16; const f32x4 a = acc[ai][bj][m][n] * rs; const u32x2 tw = *(const u32x2*)(T1 + o2); const u32x2 xw = *(const u32x2*)(X2b + o2);
                    f32x4 x;
                    x[0] = bflo(xw.x) + bflo(tw.x) * sigmoidf_(a[0]); x[1] = bfhi(xw.x) + bfhi(tw.x) * sigmoidf_(a[1]); x[2] = bflo(xw.y) + bflo(tw.y) * sigmoidf_(a[2]); x[3] = bfhi(xw.y) + bfhi(tw.y) * sigmoidf_(a[3]);
                    *(f32x4*)(XO + o2) = x; } }
    }
};
struct EpiPleFinal {
    static constexpr bool PERM = true;
    float* OUT; const bf16_t* X2b; const bf16_t* T1; const float* RS3; const float* GN; float* PART; unsigned* PCNT; LAS float* P;
    __device__ __forceinline__ void operator()(f32x4 (&acc)[2][2][4][2], const Unit& u, int wr, int wc, int fr, int fq, LAS unsigned char* scr) const {
        asm volatile("" : "+v"(fr), "+v"(fq));
        const int lane = fq * 16 + fr;
        const int row0 = u.pm * BM + wr * 64 + fr, col0 = u.pn * BM + wc * 64 + 8 * fq;
        const int rowl = u.pm * BM + wr * 64 + (lane >> 3);
        const int colx = u.pn * BM + wc * 64 + 4 * (lane & 7);
        const int coll = u.pn * BM + wc * 64 + 8 * (lane & 7);
        LAS u32x4* f0 = epi_frag(scr, fr, fq); LAS u32x4* f1 = epi_frag(scr, fr, 4 + fq); LAS u32x4* l0 = epi_line(scr, 0, lane); LAS u32x4* l1 = epi_line(scr, 1, lane);
        LAS f32x4* c0 = (LAS f32x4*)epi_frag(scr, fr, 2 * fq); LAS f32x4* c1 = (LAS f32x4*)epi_frag(scr, fr, 2 * fq + 1);
        const int tid = (wr * 4 + wc) * 64 + fq * 16 + fr;
#pragma unroll
        for (int am = 0; am < 4; ++am) {
            const int ai = am >> 1;
            u32x4 tl[2][2], xl[2][2]; float rsv[2];
#pragma unroll
            for (int mm = 0; mm < 2; ++mm) { const int m = 2 * (am & 1) + mm; rsv[mm] = RS3[row0 + ai * HALF + m * 16];
#pragma unroll
                for (int i = 0; i < 2; ++i) { const size_t o2 = (size_t)(rowl + ai * HALF + m * 16 + 8 * i) * DM + coll; tl[mm][i] = *(const u32x4*)(T1 + o2); xl[mm][i] = *(const u32x4*)(X2b + o2); } }
            asm volatile("s_waitcnt vmcnt(0)" ::: "memory");
#pragma unroll
            for (int mm = 0; mm < 2; ++mm) { const int m = 2 * (am & 1) + mm; const float rs = rsv[mm]; float ssq = 0.f;
                *l0 = tl[mm][0]; *l1 = tl[mm][1];
                const u32x4 tq[2] = {*f0, *f1};
                *l0 = xl[mm][0]; *l1 = xl[mm][1];
                const u32x4 xq[2] = {*f0, *f1};
#pragma unroll
                for (int bj = 0; bj < 2; ++bj) { const f32x4 a0 = acc[ai][bj][m][0] * rs, a1 = acc[ai][bj][m][1] * rs; const u32x4 t = tq[bj], xx = xq[bj];
                    f32x4 x0, x1;
                    x0[0] = bflo(xx.x) + bflo(t.x) * sigmoidf_(a0[0]); x0[1] = bfhi(xx.x) + bfhi(t.x) * sigmoidf_(a0[1]); x0[2] = bflo(xx.y) + bflo(t.y) * sigmoidf_(a0[2]); x0[3] = bfhi(xx.y) + bfhi(t.y) * sigmoidf_(a0[3]);
                    x1[0] = bflo(xx.z) + bflo(t.z) * sigmoidf_(a1[0]); x1[1] = bfhi(xx.z) + bfhi(t.z) * sigmoidf_(a1[1]); x1[2] = bflo(xx.w) + bflo(t.w) * sigmoidf_(a1[2]); x1[3] = bfhi(xx.w) + bfhi(t.w) * sigmoidf_(a1[3]);
                    acc[ai][bj][m][0] = x0; acc[ai][bj][m][1] = x1;
                    ssq += ((x0[0] * x0[0] + x0[1] * x0[1]) + (x0[2] * x0[2] + x0[3] * x0[3])) + ((x1[0] * x1[0] + x1[1] * x1[1]) + (x1[2] * x1[2] + x1[3] * x1[3])); }
                ssq += __shfl_xor(ssq, 16); ssq += __shfl_xor(ssq, 32);
                if (fq == 0) P[(ai * HALF + wr * 64 + m * 16 + fr) * 4 + wc] = ssq; }
        }
        asm volatile("s_waitcnt lgkmcnt(0)" ::: "memory"); __builtin_amdgcn_s_barrier(); asm volatile("" ::: "memory");
        if (tid < 256) { const f32x4 p4 = *(const LAS f32x4*)(P + tid * 4);
            __hip_atomic_store(PART + (size_t)(u.pm * BM + tid) * 4 + u.pn, (p4[0] + p4[1]) + (p4[2] + p4[3]), __ATOMIC_RELAXED, __HIP_MEMORY_SCOPE_AGENT); }
        asm volatile("s_waitcnt vmcnt(0) lgkmcnt(0)" ::: "memory"); __builtin_amdgcn_s_barrier(); asm volatile("" ::: "memory");
        if (tid < 64) {
            if (tid == 0) __hip_atomic_fetch_add(PCNT + 64 * u.pm, 1u, __ATOMIC_RELAXED, __HIP_MEMORY_SCOPE_AGENT);
            unsigned spins = 0;
            while ((unsigned)__builtin_amdgcn_readfirstlane((int)__hip_atomic_load(PCNT + 64 * u.pm, __ATOMIC_RELAXED, __HIP_MEMORY_SCOPE_AGENT)) < 4u) { __builtin_amdgcn_s_sleep(2); if (++spins > (1u << 20)) break; }
        }
        asm volatile("s_waitcnt vmcnt(0) lgkmcnt(0)" ::: "memory"); __builtin_amdgcn_s_barrier(); asm volatile("" ::: "memory");
        f32x4 gv[2][2];
#pragma unroll
        for (int bj = 0; bj < 2; ++bj)
#pragma unroll
            for (int n = 0; n < 2; ++n) gv[bj][n] = *(const f32x4*)(GN + col0 + bj * 32 + n * 4);
        f32x4 pp[2][4];
#pragma unroll
        EPI_LOOP_ROWS { const float* src = PART + (size_t)(row0 + ai * HALF + m * 16) * 4;
            asm volatile("global_load_dwordx4 %0, %1, off sc1" : "=&v"(pp[ai][m]) : "v"(src) : "memory"); }
        asm volatile("s_waitcnt vmcnt(0)" : "+v"(pp[0][0]), "+v"(pp[0][1]), "+v"(pp[0][2]), "+v"(pp[0][3]), "+v"(pp[1][0]), "+v"(pp[1][1]), "+v"(pp[1][2]), "+v"(pp[1][3]) :: "memory");
#pragma unroll
        EPI_LOOP_ROWS { const f32x4 q = pp[ai][m]; const float rstd = 1.0f / sqrtf(((q[0] + q[1]) + (q[2] + q[3])) * (1.f / DM) + EPS);
            float* op = OUT + (size_t)(rowl + ai * HALF + m * 16) * DM + colx;
#pragma unroll
            for (int bj = 0; bj < 2; ++bj) { *c0 = acc[ai][bj][m][0] * rstd * gv[bj][0]; *c1 = acc[ai][bj][m][1] * rstd * gv[bj][1];
                const f32x4 r0 = *(LAS f32x4*)l0, r1 = *(LAS f32x4*)l1;
                *(f32x4*)(op + bj * 32) = r0; *(f32x4*)(op + bj * 32 + 8 * DM) = r1; } }
    }
};
}

struct Frame {
    LAS unsigned char* lds;
    unsigned* ctl;
    unsigned char* ws;
    int tid, lane, wave, G, vcu, dry;
    const float* in[23];
    float* out;
};
enum { I_X = 0, I_P, I_ATTN_NORM, I_W_IN, I_KV_NORM, I_W_UK, I_W_UV, I_REL_BIAS, I_W_BA, I_W_BB, I_W_OUT, I_FFN_NORM, I_W_R1, I_B_R1, I_W_R2, I_B_R2,
       I_W_GATE, I_W_UP, I_W_DOWN, I_PLE_NORM, I_W_PLE_GATE, I_W_PLE, I_FINAL_NORM };
constexpr int IN_COLS = 4808;

template <class Map>
__device__ __forceinline__ void tr_item(const Map& mp, bf16_t* WT, int K, int n0, int k0, LAS float* scr_, int lane) {
    LAS unsigned* scr = (LAS unsigned*)scr_;
    const int n4 = lane & 31, hb = lane >> 5;
#pragma unroll 1
    for (int hf = 0; hf < 2; ++hf) {
        f32x4 tv[16];
#pragma unroll
        for (int j = 0; j < 16; ++j) tv[j] = mp.get4(k0 + 32 * hf + 4 * (j >> 1) + 2 * hb + (j & 1), n0 + 4 * n4);
#pragma unroll
        for (int m = 0; m < 8; ++m)
#pragma unroll
            for (int c = 0; c < 4; ++c) { const int n = 4 * n4 + c; scr[n * 32 + ((16 * hf + 2 * m + hb) ^ ((n4 ^ c) & 31))] = pk2(tv[2 * m][c], tv[2 * m + 1][c]); }
    }
    LDS_WAIT(); asm volatile("" ::: "memory");
    const int r = lane >> 3, c8 = lane & 7;
#pragma unroll
    for (int s = 0; s < 16; ++s) { const int n = 8 * s + r, f = ((n >> 2) & 31) ^ (n & 3); const LAS unsigned* p = scr + n * 32;
        u32x4 o; o.x = p[(4 * c8 + 0) ^ f]; o.y = p[(4 * c8 + 1) ^ f]; o.z = p[(4 * c8 + 2) ^ f]; o.w = p[(4 * c8 + 3) ^ f];
        *(u32x4*)(WT + (size_t)(n0 + n) * K + k0 + 8 * c8) = o; }
    LDS_WAIT(); asm volatile("" ::: "memory");
}
struct MapWin {
    const float* W;
    __device__ __forceinline__ f32x4 get4(int k, int n) const {
        int src; float sc = 1.f;
        if (n < 1152) src = 512 + (n - 1024);
        else if (n < 1216) src = 1152 + (n - 1152);
        else if (n < 1224) src = 1216 + (n - 1216);
        else if (n < 1280) src = -1;
        else if (n < 1792) src = 640 + (n - 1280);
        else if (n < 3328) { src = 1224 + (n - 1792); if (n < 2304) sc = 0.125f; }
        else if (n < 4352) src = 2760 + (n - 3328);
        else src = 3784 + (n - 4352);
        if (src < 0) return (f32x4){0.f, 0.f, 0.f, 0.f};
        return __builtin_nontemporal_load((const f32x4*)(W + (size_t)k * IN_COLS + src)) * sc;
    }
};
struct MapPlain { const float* W; int ldw; const float* gain;
    __device__ __forceinline__ f32x4 get4(int k, int n) const { const f32x4 v = __builtin_nontemporal_load((const f32x4*)(W + (size_t)k * ldw + n)); return gain ? v * gain[k] : v; } };
struct MapGU { const float* Wg; const float* Wu; const float* gain;
    __device__ __forceinline__ f32x4 get4(int k, int n) const { const int q = n >> 3; const long long dl = (n & 4) ? (long long)(Wu - Wg) : 0ll; return __builtin_nontemporal_load((const f32x4*)(Wg + dl + (long long)k * DEXP + 4 * q)) * gain[k]; } };

__device__ __forceinline__ void p0_prologue(Frame& F) {
    LAS float* scr = (LAS float*)(F.lds + F.wave * 16384);
    const int gw = F.vcu * NWAVES + F.wave, NGW = F.G * NWAVES, lane = F.lane;
    unsigned char* ws = F.ws;
    bf16_t* WinT = (bf16_t*)(ws + W_IN); bf16_t* WcombT = (bf16_t*)(ws + W_COMB); bf16_t* WbbT = (bf16_t*)(ws + W_BB); bf16_t* WoutT = (bf16_t*)(ws + W_OUT);
    constexpr int N_WIN = 34 * 16, N_BB = 8 * 8, N_OUT = 8 * 16;
    constexpr int NITEMS = N_WIN + N_BB + N_OUT;
    for (int step = 0; step < 2; ++step) {
    if ((step == 0) != ((F.wave & 1) != 0)) {
    for (int it = gw; it < NITEMS; it += NGW) {
        int r = it;
        if (r < N_WIN) { MapWin mp{F.in[I_W_IN]}; tr_item(mp, WinT, DM, 1024 + 128 * (r % 34), 64 * (r / 34), scr, lane); continue; } r -= N_WIN;
        if (r < N_BB) { MapPlain mp{F.in[I_W_BB], DM, nullptr}; tr_item(mp, WbbT, 512, 128 * (r % 8), 64 * (r / 8), scr, lane); continue; } r -= N_BB;
        { MapPlain mp{F.in[I_W_OUT], DM, nullptr}; tr_item(mp, WoutT, DM, 128 * (r % 8), 64 * (r / 8), scr, lane); }
    }
    for (int it = gw; it < 2048; it += NGW) {
        const int h = it >> 8, cb = (it >> 4) & 15, kb = it & 15, k = kb * 64 + lane;
        const float* wr_ = F.in[I_W_IN] + (size_t)k * IN_COLS + h * 64;
        f32x2 wv[32];
#pragma unroll
        for (int d = 0; d < 64; d += 4) { const f32x4 v = *(const f32x4*)(wr_ + d); wv[d / 2] = (f32x2){v[0], v[1]}; wv[d / 2 + 1] = (f32x2){v[2], v[3]}; }
        float o[8];
#pragma unroll
        for (int cc = 0; cc < 8; ++cc) { asm volatile("" ::: "memory"); const f32x2* uk = (const f32x2*)(F.in[I_W_UK] + (size_t)(h * 128 + cb * 8 + cc) * 64); f32x2 a = (f32x2){0.f, 0.f};
#pragma unroll
            for (int d = 0; d < 32; ++d) a += wv[d] * uk[d];
            o[cc] = (a[0] + a[1]) * 0.125f; }
#pragma unroll
        for (int cc = 0; cc < 8; ++cc) WinT[(size_t)(h * 128 + cb * 8 + cc) * DM + k] = (bf16_t)f2bf(o[cc]);
    }
    for (int it = gw; it < 2048; it += NGW) {
        const int h = it >> 8, cb = (it >> 4) & 15, nb = it & 15, n = nb * 64 + lane;
        f32x2 bv[32];
#pragma unroll
        for (int d = 0; d < 32; ++d) { bv[d][0] = F.in[I_W_BA][(size_t)(h * 64 + 2 * d) * DM + n]; bv[d][1] = F.in[I_W_BA][(size_t)(h * 64 + 2 * d + 1) * DM + n]; }
        float o[8];
#pragma unroll
        for (int cc = 0; cc < 8; ++cc) { asm volatile("" ::: "memory"); const f32x2* uv = (const f32x2*)(F.in[I_W_UV] + (size_t)(h * 128 + cb * 8 + cc) * 64); f32x2 a = (f32x2){0.f, 0.f};
#pragma unroll
            for (int d = 0; d < 32; ++d) a += bv[d] * uv[d];
            o[cc] = a[0] + a[1]; }
        u32x4 w; w.x = pk2(o[0], o[1]); w.y = pk2(o[2], o[3]); w.z = pk2(o[4], o[5]); w.w = pk2(o[6], o[7]);
        *(u32x4*)(WcombT + (size_t)n * DM + h * 128 + cb * 8) = w;
    }
    } else {
    {
        bf16_t* Hb = (bf16_t*)(ws + WS_H); bf16_t* Pb = (bf16_t*)(ws + WS_PB);
        f32x4 gn[4];
#pragma unroll
        for (int j = 0; j < 4; ++j) gn[j] = *(const f32x4*)(F.in[I_ATTN_NORM] + 4 * lane + 256 * j);
        const int rpw = (NTOK + NGW - 1) / NGW, mend = (gw + 1) * rpw < NTOK ? (gw + 1) * rpw : NTOK;
        for (int m0 = gw * rpw; m0 < mend; m0 += 4) {
            f32x4 v[4][4], pv[4];
#pragma unroll
            for (int u = 0; u < 4; ++u) { const int m = (m0 + u < mend) ? m0 + u : m0; const f32x4* xr = (const f32x4*)(F.in[I_X] + (size_t)m * DM) + lane;
#pragma unroll
                for (int j = 0; j < 4; ++j) v[u][j] = __builtin_nontemporal_load(xr + 64 * j);
                pv[u] = __builtin_nontemporal_load((const f32x4*)(F.in[I_P] + (size_t)m * 256) + lane); }
#pragma unroll
            for (int u = 0; u < 4; ++u) { const int m = m0 + u; if (m < mend) {
                float s = 0.f;
#pragma unroll
                for (int j = 0; j < 4; ++j) s += (v[u][j][0] * v[u][j][0] + v[u][j][1] * v[u][j][1]) + (v[u][j][2] * v[u][j][2] + v[u][j][3] * v[u][j][3]);
                const float rstd = 1.0f / sqrtf(wave_sum(s) * (1.f / DM) + EPS);
                u32x2* o8 = (u32x2*)(Hb + (size_t)m * DM) + lane;
#pragma unroll
                for (int j = 0; j < 4; ++j) { const f32x4 y = v[u][j] * rstd * gn[j]; u32x2 w; w.x = pk2(y[0], y[1]); w.y = pk2(y[2], y[3]); o8[64 * j] = w; }
                u32x2 pw; pw.x = pk2(pv[u][0], pv[u][1]); pw.y = pk2(pv[u][2], pv[u][3]); *((u32x2*)(Pb + (size_t)m * 256) + lane) = pw; } }
        }
    }
    }
    }
}

__device__ __forceinline__ void p0b_late_weights(Frame& F) {
    LAS float* scr = (LAS float*)(F.lds + F.wave * 16384);
    const int gw = F.vcu * NWAVES + F.wave, NGW = F.G * NWAVES, lane = F.lane;
    unsigned char* ws = F.ws;
    bf16_t* WguT = (bf16_t*)(ws + W_GU); bf16_t* WdnT = (bf16_t*)(ws + W_DN); bf16_t* WpgT = (bf16_t*)(ws + W_PG); bf16_t* WpleT = (bf16_t*)(ws + W_PLE);
    constexpr int N_GU = 32 * 4 * 16, N_DN = 32 * 8 * 4, N_PG = 8 * 16, N_PLE = 8 * 4;
    constexpr int NITEMS = N_GU + N_DN + N_PG + N_PLE;
    asm volatile("s_waitcnt vmcnt(0) lgkmcnt(0)" ::: "memory");
    for (int it = gw; it < NITEMS; it += NGW) {
        int r = it;
        if (r < N_GU) { const int e = r / 64, q = r % 64; MapGU mp{F.in[I_W_GATE] + (size_t)e * DM * DEXP, F.in[I_W_UP] + (size_t)e * DM * DEXP, F.in[I_FFN_NORM]};
            tr_item(mp, WguT + (size_t)e * 512 * DM, DM, 128 * (q % 4), 64 * (q / 4), scr, lane); continue; } r -= N_GU;
        if (r < N_DN) { const int e = r / 32, q = r % 32; MapPlain mp{F.in[I_W_DOWN] + (size_t)e * DEXP * DM, DM, nullptr};
            tr_item(mp, WdnT + (size_t)e * DM * DEXP, DEXP, 128 * (q % 8), 64 * (q / 8), scr, lane); continue; } r -= N_DN;
        if (r < N_PG) { MapPlain mp{F.in[I_W_PLE_GATE], DM, F.in[I_PLE_NORM]}; tr_item(mp, WpgT, DM, 128 * (r % 8), 64 * (r / 8), scr, lane); continue; } r -= N_PG;
        { MapPlain mp{F.in[I_W_PLE], DM, nullptr}; tr_item(mp, WpleT, 256, 128 * (r % 8), 64 * (r / 8), scr, lane); }
    }
    {
        bf16_t* RH = (bf16_t*)(ws + W_RHI); bf16_t* RL = (bf16_t*)(ws + W_RLO);
        for (int idx = gw * 64 + lane; idx < 48 * DM; idx += NGW * 64) {
            const int n = idx >> 10, k = idx & 1023; float v = 0.f;
            if (n < 4) v = F.in[I_W_R1][k * 4 + n]; else if (n < 36) { const int g = (n - 4) >> 3, e = (n - 4) & 7; v = F.in[I_W_R2][((size_t)g * DM + k) * 8 + e]; }
            v *= F.in[I_FFN_NORM][k];
            const unsigned hi = f2bf(v); const float lo = v - __builtin_bit_cast(float, hi << 16);
            RH[idx] = (bf16_t)hi; RL[idx] = (bf16_t)f2bf(lo);
        }
    }
}

__device__ __forceinline__ void p1b_extract(Frame& F) {
    const int gw = F.vcu * NWAVES + F.wave, NGW = F.G * NWAVES, lane = F.lane;
    const bf16_t* A = (const bf16_t*)(F.ws + WS_A); unsigned* ckvn = (unsigned*)(F.ws + S_CKVN);
    const float g0 = F.in[I_KV_NORM][2 * lane], g1 = F.in[I_KV_NORM][2 * lane + 1];
    for (int m0 = gw; m0 < NTOK; m0 += 8 * NGW) {
        unsigned wv[8];
#pragma unroll
        for (int u = 0; u < 8; ++u) { const int m = (m0 + u * NGW < NTOK) ? m0 + u * NGW : m0; const unsigned* row = (const unsigned*)(A + (size_t)m * LDA);
            wv[u] = row[CA_CKV / 2 + lane]; }
#pragma unroll
        for (int u = 0; u < 8; ++u) { const int m = m0 + u * NGW; if (m < NTOK) {
            const float a = bflo(wv[u]), b = bfhi(wv[u]);
            const float rstd = 1.0f / sqrtf(wave_sum(a * a + b * b) * (1.f / 128.f) + EPS);
            ckvn[(size_t)m * 64 + lane] = pk2(a * rstd * g0, b * rstd * g1);
            } }
    }
}

__device__ __forceinline__ float wave_max(float v) {
#pragma unroll
    for (int o = 1; o < 64; o <<= 1) v = fmaxf(v, __shfl_xor(v, o));
    return v;
}
__device__ __forceinline__ float wave_min(float v) {
#pragma unroll
    for (int o = 1; o < 64; o <<= 1) v = fminf(v, __shfl_xor(v, o));
    return v;
}
__device__ __forceinline__ unsigned wave_scan_incl(unsigned v) {
    v += (unsigned)__builtin_amdgcn_update_dpp(0, (int)v, 0x111, 0xf, 0xf, false);
    v += (unsigned)__builtin_amdgcn_update_dpp(0, (int)v, 0x112, 0xf, 0xf, false);
    v += (unsigned)__builtin_amdgcn_update_dpp(0, (int)v, 0x114, 0xf, 0xf, false);
    v += (unsigned)__builtin_amdgcn_update_dpp(0, (int)v, 0x118, 0xf, 0xf, false);
    v += (unsigned)__builtin_amdgcn_update_dpp(0, (int)v, 0x142, 0xa, 0xf, false);
    v += (unsigned)__builtin_amdgcn_update_dpp(0, (int)v, 0x143, 0xc, 0xf, false);
    return v;
}
template <int CTRL> __device__ __forceinline__ float dpp_f(float x) { return __builtin_bit_cast(float, __builtin_amdgcn_update_dpp(__builtin_bit_cast(int, x), __builtin_bit_cast(int, x), CTRL, 0xf, 0xf, false)); }
__device__ __forceinline__ float rdl(float x, int l) { return __builtin_bit_cast(float, __builtin_amdgcn_readlane(__builtin_bit_cast(int, x), l)); }
__device__ __forceinline__ float wave_max_u(float x) {
    x = fmaxf(x, dpp_f<0xB1>(x)); x = fmaxf(x, dpp_f<0x4E>(x)); x = fmaxf(x, dpp_f<0x141>(x)); x = fmaxf(x, dpp_f<0x140>(x));
    return fmaxf(fmaxf(rdl(x, 0), rdl(x, 16)), fmaxf(rdl(x, 32), rdl(x, 48)));
}
__device__ __forceinline__ float wave_min_u(float x) {
    x = fminf(x, dpp_f<0xB1>(x)); x = fminf(x, dpp_f<0x4E>(x)); x = fminf(x, dpp_f<0x141>(x)); x = fminf(x, dpp_f<0x140>(x));
    return fminf(fminf(rdl(x, 0), rdl(x, 16)), fminf(rdl(x, 32), rdl(x, 48)));
}
__device__ __noinline__ void topk_tie_lds(const LAS float* sc, int t, unsigned short* out, int lane, float lo, float hi, int chi, LAS unsigned* scr) {
    const int nr = (t + 64) >> 6;
    const float NINF = -__builtin_inff();
#define SCV(rr) ((64 * (rr) + lane <= t) ? sc[64 * (rr) + lane] : NINF)
    LAS float* cv = (LAS float*)scr; LAS int* ci = (LAS int*)(scr + 64);
    int m = 0;
    for (int rr = 0; rr < nr; ++rr) { const float x = SCV(rr); const bool e = x >= lo && x < hi;
        const unsigned long long me = __ballot(e);
        const int pos = m + (int)__builtin_amdgcn_mbcnt_hi((unsigned)(me >> 32), __builtin_amdgcn_mbcnt_lo((unsigned)me, 0u));
        if (e && pos < 64) { cv[pos] = x; ci[pos] = 64 * rr + lane; }
        m += __builtin_popcountll(me); }
    asm volatile("s_waitcnt lgkmcnt(0)" ::: "memory");
    float Tv; int Ti;
    if (m <= 64) {
        const int need = 256 - chi;
        const float myv = lane < m ? cv[lane] : NINF; const int myi = lane < m ? ci[lane] : 0x7fffffff;
        int rank = 0;
        for (int j = 0; j < m; ++j) { const float vj = rdl(myv, j); const int ij = __builtin_amdgcn_readlane(myi, j); rank += (vj > myv || (vj == myv && ij < myi)) ? 1 : 0; }
        const unsigned long long mt = __ballot(lane < m && rank == need - 1);
        const int tl = (int)__builtin_ctzll(mt | (1ull << 63));
        Tv = rdl(myv, tl); Ti = __builtin_amdgcn_readlane(myi, tl);
    } else {
        for (int it = 0; it < 200; ++it) {
            const float mid = 0.5f * lo + 0.5f * hi;
            if (!(mid > lo && mid < hi)) break;
            int c = 0;
            for (int rr = 0; rr < nr; ++rr) c += __builtin_popcountll(__ballot(SCV(rr) >= mid));
            if (c >= 256) lo = mid; else { hi = mid; chi = c; }
        }
        int need = 256 - chi, eqb = 0; Tv = lo; Ti = -1;
        for (int rr = 0; rr < nr; ++rr) { const bool eq = SCV(rr) == lo; const unsigned long long meq = __ballot(eq);
            const int rk = eqb + (int)__builtin_amdgcn_mbcnt_hi((unsigned)(meq >> 32), __builtin_amdgcn_mbcnt_lo((unsigned)meq, 0u));
            const unsigned long long hit = __ballot(eq && rk == need - 1);
            if (hit) Ti = 64 * rr + (int)__builtin_ctzll(hit);
            eqb += __builtin_popcountll(meq); }
        hi = __builtin_inff(); lo = Tv;
    }
    int base = 0;
    for (int rr = 0; rr < nr; ++rr) { const float x = SCV(rr); const int idx = 64 * rr + lane;
        const bool sl = (x >= hi) || (x >= lo && x < hi && (x > Tv || (x == Tv && idx <= Ti)));
        const unsigned long long ms = __ballot(sl);
        const int pos = base + (int)__builtin_amdgcn_mbcnt_hi((unsigned)(ms >> 32), __builtin_amdgcn_mbcnt_lo((unsigned)ms, 0u));
        if (sl && pos < 256) out[pos] = (unsigned short)idx;
        base += __builtin_popcountll(ms); }
#undef SCV
}
template <int PAR>
__device__ __forceinline__ void topk_fallback(const float (&v)[64], int t, unsigned short* out, int lane, LAS float* sc, float lo, float hi, int chi) {
    asm volatile("s_waitcnt lgkmcnt(0)" ::: "memory");
#pragma unroll
    for (int rr = 0; rr < 32; ++rr) sc[64 * rr + lane] = v[2 * rr + PAR];
    asm volatile("s_waitcnt lgkmcnt(0)" ::: "memory");
    topk_tie_lds(sc, t, out, lane, lo, hi, chi, (LAS unsigned*)(sc + 2048));
}
template <int PAR>
__device__ __forceinline__ bool topk_fast(const float (&v)[64], int t, unsigned short* out, int lane, LAS unsigned short* cb, float& blo, float& bhi, int& bchi) {
    const int n = t + 1;
    if (n <= 256) {
#pragma unroll
        for (int j = 0; j < 4; ++j) { const int idx = 64 * j + lane; out[idx] = (unsigned short)(idx < n ? idx : 0); }
        return true;
    }
    const int ng = (n + 255) >> 8;
    const float NINF = -__builtin_inff(), PINF = __builtin_inff();
    float mx0 = NINF, mx1 = NINF, mn0 = PINF, mn1 = PINF;
#pragma unroll
    for (int g = 0; g < 8; ++g) if (g < ng) {
#pragma unroll
        for (int j = 0; j < 4; j += 2) { const float x = v[2 * (4 * g + j) + PAR], y = v[2 * (4 * g + j + 1) + PAR];
            mx0 = fmaxf(mx0, x); mx1 = fmaxf(mx1, y); mn0 = fminf(mn0, x == NINF ? PINF : x); mn1 = fminf(mn1, y == NINF ? PINF : y); } }
    float hi = __builtin_inff(), lo = wave_min_u(fminf(mn0, mn1)); const float vmax = wave_max_u(fmaxf(mx0, mx1));
    int chi = 0;
    const int slots = 256 * ng;
    unsigned cl0 = 0, cl1 = 0, cl2 = 0, cl3 = 0;
    bool found = false;
    for (int it = 0; it < 24; ++it) {
        const float mid = (it == 0) ? vmax : 0.5f * lo + 0.5f * hi;
        if (!(mid > lo && mid < hi)) break;
        cl0 = cl1 = cl2 = cl3 = 0;
#pragma unroll
        for (int g = 0; g < 8; ++g) if (g < ng) {
            cl0 += __builtin_bit_cast(unsigned, v[2 * (4 * g + 0) + PAR] - mid) >> 31; cl1 += __builtin_bit_cast(unsigned, v[2 * (4 * g + 1) + PAR] - mid) >> 31;
            cl2 += __builtin_bit_cast(unsigned, v[2 * (4 * g + 2) + PAR] - mid) >> 31; cl3 += __builtin_bit_cast(unsigned, v[2 * (4 * g + 3) + PAR] - mid) >> 31; }
        const unsigned below = (unsigned)__builtin_amdgcn_readlane((int)wave_scan_incl((cl0 + cl1) + (cl2 + cl3)), 63);
        const int c = slots - (int)below;
        if (c == 256) { found = true; lo = mid; break; }
        if (c > 256) lo = mid; else { hi = mid; chi = c; }
    }
    if (!found) { blo = lo; bhi = hi; bchi = chi; return false; }
    const float T = lo;
    const unsigned mine = (unsigned)(4 * ng) - ((cl0 + cl1) + (cl2 + cl3));
    unsigned pos = wave_scan_incl(mine) - mine;
#pragma unroll
    for (int g = 0; g < 8; ++g) if (g < ng) {
#pragma unroll
        for (int j = 0; j < 4; ++j) { const int rr = 4 * g + j; const unsigned sel = 1u - (__builtin_bit_cast(unsigned, v[2 * rr + PAR] - T) >> 31);
            int ln = lane; asm volatile("" : "+v"(ln));
            LAS unsigned short* dst = sel ? cb + pos : cb + 256 + ln;
            *dst = (unsigned short)(64 * rr + ln); pos += sel; } }
    asm volatile("s_waitcnt lgkmcnt(0)" ::: "memory");
    *(u32x2*)(out + 4 * lane) = *(const LAS u32x2*)(cb + 4 * lane);
    return true;
}

#ifndef P2_DEPTH
#define P2_DEPTH 3
#endif
__device__ __forceinline__ void p2_unit(Frame& F, int b, int qb) {
    const int lane = F.lane, w = F.wave, r = lane & 31, hh = lane >> 5;
    const bf16_t* A = (const bf16_t*)(F.ws + WS_A);
    const bf16_t* KI = A + (size_t)b * SEQ * LDA + CA_KIDX;
    unsigned short* SEL = (unsigned short*)(F.ws + S_SEL);
    const int tq0 = qb * 32 + 4 * w;
    bf16x8 af[4];
    { const bf16_t* qrow = A + (size_t)(b * SEQ + tq0 + (r >> 3)) * LDA + CA_QIDX + (r & 7) * 64 + 8 * hh;
#pragma unroll
      for (int s = 0; s < 4; ++s) af[s] = *(const bf16x8*)(qrow + 16 * s); }
    float wq[16];
#pragma unroll
    for (int i = 0; i < 16; ++i) wq[i] = bf2f(A[(size_t)(b * SEQ + tq0 + (i >> 2)) * LDA + CA_WIDX + (i & 3) + 4 * hh]);
    const float NINF = -__builtin_inff();
    float S01[64], S23[64];
#pragma unroll
    for (int i = 0; i < 64; ++i) { S01[i] = NINF; S23[i] = NINF; }
    const int nkt = qb + 1;
    const bool dm01 = r > 4 * w + hh, dm23 = r > 4 * w + 2 + hh;
    const bf16_t* krow = (const bf16_t*)(F.ws + S_KIDX) + (size_t)b * SEQ * 64 + 8 * lane;
    bf16x8 bfr[P2_DEPTH][4];
#pragma unroll
    for (int d = 0; d < P2_DEPTH; ++d) if (d < nkt) {
#pragma unroll
        for (int s = 0; s < 4; ++s) bfr[d][s] = gld<bf16x8>(krow + 2048 * d + 512 * s); }
#pragma unroll
    for (int kt = 0; kt < 64; ++kt) if (kt < nkt) {
        asm volatile("" : "+v"(krow));
        f32x16 acc;
#pragma unroll
        for (int i = 0; i < 16; ++i) acc[i] = 0.f;
#pragma unroll
        for (int s = 0; s < 4; ++s) acc = __builtin_amdgcn_mfma_f32_32x32x16_bf16(af[s], bfr[kt % P2_DEPTH][s], acc, 0, 0, 0);
        if (kt + P2_DEPTH < nkt) {
#pragma unroll
            for (int s = 0; s < 4; ++s) bfr[kt % P2_DEPTH][s] = gld<bf16x8>(krow + 2048 * P2_DEPTH + 512 * s); }
        float p[4];
#pragma unroll
        for (int q = 0; q < 4; ++q) p[q] = (wq[4 * q] * fmaxf(acc[4 * q], 0.f) + wq[4 * q + 1] * fmaxf(acc[4 * q + 1], 0.f)) + (wq[4 * q + 2] * fmaxf(acc[4 * q + 2], 0.f) + wq[4 * q + 3] * fmaxf(acc[4 * q + 3], 0.f));
        auto r01 = __builtin_amdgcn_permlane32_swap(__builtin_bit_cast(unsigned, p[0]), __builtin_bit_cast(unsigned, p[1]), false, false);
        auto r23 = __builtin_amdgcn_permlane32_swap(__builtin_bit_cast(unsigned, p[2]), __builtin_bit_cast(unsigned, p[3]), false, false);
        float s01 = __builtin_bit_cast(float, (unsigned)r01[0]) + __builtin_bit_cast(float, (unsigned)r01[1]);
        float s23 = __builtin_bit_cast(float, (unsigned)r23[0]) + __builtin_bit_cast(float, (unsigned)r23[1]);
        if (kt == qb) { if (dm01) s01 = NINF; if (dm23) s23 = NINF; }
        S01[kt] = s01; S23[kt] = s23;
        krow += 2048;
    }
#pragma unroll
    for (int rr = 0; rr < 32; ++rr) {
        auto a = __builtin_amdgcn_permlane32_swap(__builtin_bit_cast(unsigned, S01[2 * rr]), __builtin_bit_cast(unsigned, S01[2 * rr + 1]), false, false);
        S01[2 * rr] = __builtin_bit_cast(float, (unsigned)a[0]); S01[2 * rr + 1] = __builtin_bit_cast(float, (unsigned)a[1]);
        auto c2 = __builtin_amdgcn_permlane32_swap(__builtin_bit_cast(unsigned, S23[2 * rr]), __builtin_bit_cast(unsigned, S23[2 * rr + 1]), false, false);
        S23[2 * rr] = __builtin_bit_cast(float, (unsigned)c2[0]); S23[2 * rr + 1] = __builtin_bit_cast(float, (unsigned)c2[1]);
    }
    unsigned short* o = SEL + (size_t)(b * SEQ + tq0) * 256;
    LAS float* scf = (LAS float*)(F.lds + w * 16384); float blo = 0.f, bhi = 0.f; int bchi = 0;
    LAS unsigned short* dmy = (LAS unsigned short*)(F.lds + w * 16384 + 12288);
    if (!topk_fast<0>(S01, tq0 + 0, o, lane, dmy, blo, bhi, bchi)) topk_fallback<0>(S01, tq0 + 0, o, lane, scf, blo, bhi, bchi);
    if (!topk_fast<1>(S01, tq0 + 1, o + 256, lane, dmy, blo, bhi, bchi)) topk_fallback<1>(S01, tq0 + 1, o + 256, lane, scf, blo, bhi, bchi);
    if (!topk_fast<0>(S23, tq0 + 2, o + 512, lane, dmy, blo, bhi, bchi)) topk_fallback<0>(S23, tq0 + 2, o + 512, lane, scf, blo, bhi, bchi);
    if (!topk_fast<1>(S23, tq0 + 3, o + 768, lane, dmy, blo, bhi, bchi)) topk_fallback<1>(S23, tq0 + 3, o + 768, lane, scf, blo, bhi, bchi);
}
__device__ __forceinline__ void p2_indexer(Frame& F) {
    for (int u = F.vcu; u < 1024; u += F.G) {
        const int c = u & 255, i = u >> 8, b = c >> 4, j = c & 15;
        const int qb = (i == 0) ? j : (i == 1) ? 63 - j : (i == 2) ? 16 + j : 47 - j;
        p2_unit(F, b, qb);
    }
}

__device__ __forceinline__ unsigned offb(unsigned row, unsigned ch) { return 256u * row + 16u * (ch ^ (((row & 3u) << 2) | ((row >> 2) & 3u))); }
__device__ __forceinline__ s16x4 ds_tr(LAS unsigned char* p) { return __builtin_bit_cast(s16x4, __builtin_amdgcn_ds_read_tr16_b64_v4i16((LAS v4i16_t*)p)); }
constexpr int P3_IDXROW = MISC_OFF + 1024, P3_LUT = MISC_OFF + 4096;
__device__ __forceinline__ int t5_bucket(int d) {
    if (d < 16) return d;
    const int lg = 16 + (int)(__logf((float)d / 16.0f) / 2.0794415416798357f * 16.0f);
    return lg < 31 ? lg : 31;
}
__device__ __forceinline__ float xmax4(float x) {
    auto a = __builtin_amdgcn_permlane32_swap(__builtin_bit_cast(unsigned, x), __builtin_bit_cast(unsigned, x), false, false);
    x = fmaxf(__builtin_bit_cast(float, (unsigned)a[0]), __builtin_bit_cast(float, (unsigned)a[1]));
    auto b = __builtin_amdgcn_permlane16_swap(__builtin_bit_cast(unsigned, x), __builtin_bit_cast(unsigned, x), false, false);
    return fmaxf(__builtin_bit_cast(float, (unsigned)b[0]), __builtin_bit_cast(float, (unsigned)b[1]));
}
__device__ __forceinline__ float xsum4(float x) {
    auto a = __builtin_amdgcn_permlane32_swap(__builtin_bit_cast(unsigned, x), __builtin_bit_cast(unsigned, x), false, false);
    x = __builtin_bit_cast(float, (unsigned)a[0]) + __builtin_bit_cast(float, (unsigned)a[1]);
    auto b = __builtin_amdgcn_permlane16_swap(__builtin_bit_cast(unsigned, x), __builtin_bit_cast(unsigned, x), false, false);
    return __builtin_bit_cast(float, (unsigned)b[0]) + __builtin_bit_cast(float, (unsigned)b[1]);
}
__device__ __forceinline__ void p3_query(Frame& F, int b, int t, const bf16x8 bfrag) {
    const int lane = F.lane, w = F.wave, l15 = lane & 15, g4 = lane >> 4;
    bf16_t* A = (bf16_t*)(F.ws + WS_A);
    const unsigned char* ckv = F.ws + S_CKVN + (size_t)b * SEQ * 256;
    const unsigned short* selq = (const unsigned short*)(F.ws + S_SEL) + (size_t)(b * SEQ + t) * 256;
    LAS unsigned char* buf = F.lds + w * 16384;
    LAS unsigned short* idxrow = (LAS unsigned short*)(F.lds + P3_IDXROW + w * 128);
    const LAS unsigned char* lut = F.lds + P3_LUT;
    bf16_t* qrow = A + (size_t)(b * SEQ + t) * LDA + CA_QABS;
    bf16x8 qf[4];
#pragma unroll
    for (int s = 0; s < 4; ++s) { if (l15 < 8) qf[s] = *(const bf16x8*)(qrow + l15 * 128 + 32 * s + 8 * g4); else qf[s] = (bf16x8){0, 0, 0, 0, 0, 0, 0, 0}; }
    const float NINF = -__builtin_inff();
    float m = NINF, lsum = 0.f;
    f32x4 O[8];
#pragma unroll
    for (int c = 0; c < 8; ++c) O[c] = (f32x4){0.f, 0.f, 0.f, 0.f};
    const int nvalid = (t + 1 < 256) ? t + 1 : 256, nchunk = (nvalid + 63) >> 6;
    const unsigned RT = 8 * ((unsigned)l15 >> 2) + ((unsigned)l15 & 3);
    u32x4 ia[4][2]; unsigned short mya[4];
#pragma unroll
    for (int ch = 0; ch < 4; ++ch) if (ch < nchunk) { ia[ch][0] = *(const u32x4*)(selq + 64 * ch + 16 * g4); ia[ch][1] = *(const u32x4*)(selq + 64 * ch + 16 * g4 + 8); mya[ch] = selq[64 * ch + 16 * g4 + l15]; }
#pragma unroll
    for (int ch = 0; ch < 4; ++ch) if (ch < nchunk) {
        idxrow[4 * l15 + g4] = mya[ch];
        const unsigned ir[8] = {ia[ch][0].x, ia[ch][0].y, ia[ch][0].z, ia[ch][0].w, ia[ch][1].x, ia[ch][1].y, ia[ch][1].z, ia[ch][1].w};
#pragma unroll
        for (int g = 0; g < 16; ++g) {
            const unsigned idx = (g & 1) ? (ir[g >> 1] >> 16) : (ir[g >> 1] & 0xffffu);
            const unsigned cpos = (unsigned)l15 ^ (((unsigned)g4 << 2) | (unsigned)(g & 3));
            __builtin_amdgcn_global_load_lds((const unsigned*)(ckv + (size_t)((idx << 8) + (cpos << 4))), (LAS unsigned*)(buf + g * 1024), 16, 0, 0);
        }
        asm volatile("s_waitcnt vmcnt(0) lgkmcnt(0)" ::: "memory");
        f32x4 st[2][2];
        bf16x8 oh[2][2];
#pragma unroll
        for (int ks = 0; ks < 2; ++ks)
#pragma unroll
            for (int u = 0; u < 2; ++u) { int d = t - (int)idxrow[32 * ks + 4 * u + RT]; d = d > 128 ? 128 : d; oh[ks][u] = *(const LAS bf16x8*)(lut + d * 64 + g4 * 16); }
#pragma unroll
        for (int ks = 0; ks < 2; ++ks)
#pragma unroll
            for (int u = 0; u < 2; ++u) { f32x4 acc = (f32x4){0.f, 0.f, 0.f, 0.f}; const unsigned R = 32 * ks + 4 * u + RT;
#pragma unroll
                for (int s = 0; s < 4; ++s) { const bf16x8 a = *(const LAS bf16x8*)(buf + offb(R, 4 * s + g4)); acc = __builtin_amdgcn_mfma_f32_16x16x32_bf16(a, qf[s], acc, 0, 0, 0); }
                st[ks][u] = __builtin_amdgcn_mfma_f32_16x16x32_bf16(oh[ks][u], bfrag, acc, 0, 0, 0); }
        if (64 * (ch + 1) > nvalid) {
#pragma unroll
            for (int ks = 0; ks < 2; ++ks)
#pragma unroll
                for (int u = 0; u < 2; ++u)
#pragma unroll
                    for (int rg = 0; rg < 4; ++rg) { const int slot = 64 * ch + 16 * rg + 8 * ks + 2 * g4 + u; if (slot >= nvalid) st[ks][u][rg] = NINF; } }
        float cm = NINF;
#pragma unroll
        for (int ks = 0; ks < 2; ++ks)
#pragma unroll
            for (int u = 0; u < 2; ++u) cm = fmaxf(fmaxf(cm, fmaxf(st[ks][u][0], st[ks][u][1])), fmaxf(st[ks][u][2], st[ks][u][3]));
        cm = xmax4(cm);
        if (__any(cm > m + 8.0f)) {
            const float mnew = fmaxf(m, cm), alpha = fast_exp(m - mnew);
            m = mnew; lsum *= alpha;
            float aO[4];
#pragma unroll
            for (int rg = 0; rg < 4; ++rg) aO[rg] = __shfl(alpha, 4 * g4 + rg);
#pragma unroll
            for (int c = 0; c < 8; ++c) { O[c][0] *= aO[0]; O[c][1] *= aO[1]; O[c][2] *= aO[2]; O[c][3] *= aO[3]; }
        }
        float ps = 0.f;
#pragma unroll
        for (int ks = 0; ks < 2; ++ks)
#pragma unroll
            for (int u = 0; u < 2; ++u)
#pragma unroll
                for (int rg = 0; rg < 4; ++rg) { const float pv = fast_exp(st[ks][u][rg] - m); st[ks][u][rg] = pv; ps += pv; }
        lsum += ps;
        bf16x8 pf[2];
#pragma unroll
        for (int ks = 0; ks < 2; ++ks) { u32x4 pw; pw.x = cvt_pk_bf16(st[ks][0][0], st[ks][0][1]); pw.y = cvt_pk_bf16(st[ks][0][2], st[ks][0][3]); pw.z = cvt_pk_bf16(st[ks][1][0], st[ks][1][1]); pw.w = cvt_pk_bf16(st[ks][1][2], st[ks][1][3]);
            pf[ks] = __builtin_bit_cast(bf16x8, pw); }
#pragma unroll
        for (int c = 0; c < 8; ++c)
#pragma unroll
            for (int ks = 0; ks < 2; ++ks) {
                const unsigned q = (unsigned)l15 >> 2, p = (unsigned)lane & 3u;
                const s16x4 v0 = ds_tr(buf + offb(32 * ks + 8 * g4 + 0 + q, 2 * c + (p >> 1)) + 8 * (p & 1));
                const s16x4 v1 = ds_tr(buf + offb(32 * ks + 8 * g4 + 4 + q, 2 * c + (p >> 1)) + 8 * (p & 1));
                const bf16x8 vb = (bf16x8){v0[0], v0[1], v0[2], v0[3], v1[0], v1[1], v1[2], v1[3]};
                O[c] = __builtin_amdgcn_mfma_f32_16x16x32_bf16(pf[ks], vb, O[c], 0, 0, 0);
            }
        asm volatile("s_waitcnt lgkmcnt(0)" ::: "memory");
    }
    const float lt = xsum4(lsum);
    float inv[4];
#pragma unroll
    for (int rg = 0; rg < 4; ++rg) inv[rg] = 1.0f / __shfl(lt, 4 * g4 + rg);
    if (g4 < 2 && !F.dry) {
#pragma unroll
        for (int rg = 0; rg < 4; ++rg)
#pragma unroll
            for (int c = 0; c < 8; ++c) qrow[(4 * g4 + rg) * 128 + 16 * c + l15] = (bf16_t)f2bf(O[c][rg] * inv[rg]);
    }
}
__device__ __forceinline__ void p3_sparse_attn(Frame& F) {
    LAS unsigned short* lut = (LAS unsigned short*)(F.lds + P3_LUT);
    for (int i = F.tid; i < 129 * 32; i += NWAVES * 64) lut[i] = (unsigned short)((t5_bucket(i >> 5) == (i & 31)) ? 0x3F80 : 0);
    bf16x8 bfrag;
    { const int l15 = F.lane & 15, g4 = F.lane >> 4; unsigned wv[4];
#pragma unroll
      for (int j = 0; j < 4; ++j) wv[j] = (l15 < 8) ? pk2(F.in[I_REL_BIAS][(8 * g4 + 2 * j) * 8 + l15], F.in[I_REL_BIAS][(8 * g4 + 2 * j + 1) * 8 + l15]) : 0u;
      bfrag = __builtin_bit_cast(bf16x8, (u32x4){wv[0], wv[1], wv[2], wv[3]}); }
    __syncthreads();
    if (F.G == 256) {
        const int x = F.vcu >> 5, wl = (F.vcu & 31) * 8 + F.wave;
        for (int i = 0; i < 16; ++i) { const int qi = wl + 256 * i; p3_query(F, x + 8 * (qi >> 11), qi & 2047, bfrag); }
    } else {
        for (int q = F.vcu * NWAVES + F.wave; q < NTOK; q += F.G * NWAVES) p3_query(F, q >> 11, q & 2047, bfrag);
    }
}

__device__ __forceinline__ void p4_issue(const bf16_t* A, int b, int h, int k0, LAS unsigned char* dst, int lane) {
#pragma unroll
    for (int g = 0; g < 4; ++g) { const int row = 8 * g + (lane >> 3), pos = lane & 7;
        const bf16_t* src = A + (size_t)(b * SEQ + k0 + row) * LDA + h * 64;
        __builtin_amdgcn_global_load_lds((const unsigned*)(src + CA_KB + 8 * (pos ^ ((row >> 1) & 7))), (LAS unsigned*)(dst + g * 1024), 16, 0, 0);
        __builtin_amdgcn_global_load_lds((const unsigned*)(src + CA_VB + 8 * (pos ^ (((row >> 1) & 1) << 2))), (LAS unsigned*)(dst + 4096 + g * 1024), 16, 0, 0); }
}
__device__ __forceinline__ void p4_unit(Frame& F, int b, int h, int qt) {
    const int lane = F.lane, w = F.wave, r = lane & 31, hh = lane >> 5;
    bf16_t* A = (bf16_t*)(F.ws + WS_A);
    LAS unsigned char* wbuf = F.lds + w * 16384;
    const int t0 = 32 * qt;
    bf16_t* qrow = A + (size_t)(b * SEQ + t0 + r) * LDA + CA_QB + h * 64;
    bf16x8 qf[4];
#pragma unroll
    for (int s = 0; s < 4; ++s) qf[s] = *(const bf16x8*)(qrow + 16 * s + 8 * hh);
    asm volatile("s_waitcnt vmcnt(0)" ::: "memory");
    f32x16 o0, o1;
#pragma unroll
    for (int i = 0; i < 16; ++i) { o0[i] = 0.f; o1[i] = 0.f; }
    float carry = 0.f;
    const unsigned q4 = (unsigned)(lane & 15) >> 2, p4 = (unsigned)lane & 3u, blk = (unsigned)(lane >> 4) & 1u;
    for (int kt = qt; kt >= 0; --kt) {
        LAS unsigned char* kb = wbuf; LAS unsigned char* vb = kb + 4096;
        asm volatile("s_waitcnt lgkmcnt(0)" ::: "memory");
        p4_issue(A, b, h, 32 * kt, wbuf, lane);
        asm volatile("s_waitcnt vmcnt(0)" ::: "memory");
        f32x16 z;
#pragma unroll
        for (int i = 0; i < 16; ++i) z[i] = 0.f;
#pragma unroll
        for (int s = 0; s < 4; ++s) { const bf16x8 kf = *(const LAS bf16x8*)(kb + r * 128 + 16 * ((2 * s + hh) ^ ((r >> 1) & 7))); z = __builtin_amdgcn_mfma_f32_32x32x16_bf16(kf, qf[s], z, 0, 0, 0); }
        const bool diag = (kt == qt);
        float L[16], lsg[16];
#pragma unroll
        for (int i = 0; i < 16; ++i) { const int key = (i & 3) + 8 * (i >> 2) + 4 * hh; const bool msk = diag && !(key < r);
            const float zz = z[i]; const float sp = fmaxf(zz, 0.f) + 0.69314718056f * __builtin_amdgcn_logf(1.0f + __builtin_amdgcn_exp2f(-fabsf(zz) * 1.44269504089f));
            L[i] = msk ? 0.f : -sp; lsg[i] = msk ? -__builtin_inff() : zz - sp; }
        float Gs[4], PG[4];
#pragma unroll
        for (int i4 = 0; i4 < 4; ++i4) { Gs[i4] = (L[4 * i4] + L[4 * i4 + 1]) + (L[4 * i4 + 2] + L[4 * i4 + 3]); PG[i4] = __shfl_xor(Gs[i4], 32); }
        float suf[4]; float run = 0.f;
#pragma unroll
        for (int i4 = 3; i4 >= 0; --i4) { suf[i4] = run + (hh == 0 ? PG[i4] : 0.f); run += Gs[i4] + PG[i4]; }
        float a[16];
#pragma unroll
        for (int i4 = 0; i4 < 4; ++i4) { float aft = carry + suf[i4];
#pragma unroll
            for (int rr = 3; rr >= 0; --rr) { const int i = 4 * i4 + rr; a[i] = fast_exp(lsg[i] + aft); aft += L[i]; } }
        carry += run;
        bf16x8 pb[2];
#pragma unroll
        for (int s = 0; s < 2; ++s) { u32x4 pw; pw.x = cvt_pk_bf16(a[8 * s], a[8 * s + 1]); pw.y = cvt_pk_bf16(a[8 * s + 2], a[8 * s + 3]); pw.z = cvt_pk_bf16(a[8 * s + 4], a[8 * s + 5]); pw.w = cvt_pk_bf16(a[8 * s + 6], a[8 * s + 7]);
            pb[s] = __builtin_bit_cast(bf16x8, pw); }
#pragma unroll
        for (int s = 0; s < 2; ++s) {
            const unsigned ra = 16 * s + 4 * hh + q4, rb = ra + 8;
            const unsigned ca = 2 * blk + (p4 >> 1), cb = 4 + ca, sa = ((ra >> 1) & 1u) << 2, sb = ((rb >> 1) & 1u) << 2;
            const s16x4 a0 = ds_tr(vb + ra * 128 + 16 * (ca ^ sa) + 8 * (p4 & 1));
            const s16x4 a1 = ds_tr(vb + rb * 128 + 16 * (ca ^ sb) + 8 * (p4 & 1));
            const s16x4 c0 = ds_tr(vb + ra * 128 + 16 * (cb ^ sa) + 8 * (p4 & 1));
            const s16x4 c1 = ds_tr(vb + rb * 128 + 16 * (cb ^ sb) + 8 * (p4 & 1));
            const bf16x8 va0 = (bf16x8){a0[0], a0[1], a0[2], a0[3], a1[0], a1[1], a1[2], a1[3]};
            const bf16x8 va1 = (bf16x8){c0[0], c0[1], c0[2], c0[3], c1[0], c1[1], c1[2], c1[3]};
            o0 = __builtin_amdgcn_mfma_f32_32x32x16_bf16(va0, pb[s], o0, 0, 0, 0);
            o1 = __builtin_amdgcn_mfma_f32_32x32x16_bf16(va1, pb[s], o1, 0, 0, 0);
        }
        if (__all(carry < -104.0f)) break;
    }
    asm volatile("s_waitcnt vmcnt(0)" ::: "memory");
    if (!F.dry)
#pragma unroll
    for (int i4 = 0; i4 < 4; ++i4) {
        u32x2 w0; w0.x = cvt_pk_bf16(o0[4 * i4], o0[4 * i4 + 1]); w0.y = cvt_pk_bf16(o0[4 * i4 + 2], o0[4 * i4 + 3]); *(u32x2*)(qrow + 8 * i4 + 4 * hh) = w0;
        u32x2 w1; w1.x = cvt_pk_bf16(o1[4 * i4], o1[4 * i4 + 1]); w1.y = cvt_pk_bf16(o1[4 * i4 + 2], o1[4 * i4 + 3]); *(u32x2*)(qrow + 32 + 8 * i4 + 4 * hh) = w1;
    }
}
__device__ __forceinline__ void p4_stickbreak(Frame& F) {
    if (F.G == 256) {
        const int x = F.vcu >> 5, wl = (F.vcu & 31) * 8 + F.wave, bh = wl >> 4, j = wl & 15;
        const int b = x + 8 * (bh >> 3), h = bh & 7;
        p4_unit(F, b, h, j); p4_unit(F, b, h, 63 - j); p4_unit(F, b, h, 16 + j); p4_unit(F, b, h, 47 - j);
    } else {
        for (int u = F.vcu * NWAVES + F.wave; u < NB * 8 * 64; u += F.G * NWAVES) p4_unit(F, u >> 9, (u >> 6) & 7, u & 63);
    }
}

constexpr int P8_LG = 0;
__device__ __forceinline__ void p8_router(Frame& F) {
    const int lane = F.lane, w = F.wave, l15 = lane & 15, g4 = lane >> 4;
    const bf16_t* X1b = (const bf16_t*)(F.ws + WS_A);
    const bf16_t* RH = (const bf16_t*)(F.ws + W_RHI); const bf16_t* RL = (const bf16_t*)(F.ws + W_RLO);
    int* perm = (int*)(F.ws + S_PERM); float* RSa = (float*)(F.ws + S_RS); float* CWa = (float*)(F.ws + S_CW); int* tokslot = (int*)(F.ws + S_TOKSLOT);
    unsigned* cnt = F.ctl + CW_CNT + (F.dry ? 4096 : 0);
    LAS float* lg = (LAS float*)(F.lds + P8_LG + w * 4096);
    LAS unsigned* lcnt = (LAS unsigned*)(F.lds + MISC_OFF + 8192);
    const int nround = (NTOK / 16 + F.G * NWAVES - 1) / (F.G * NWAVES);
    for (int rd = 0; rd < nround; ++rd) {
        const int grp0 = rd * F.G * NWAVES + F.vcu * NWAVES + w; const bool gvalid = grp0 < NTOK / 16; const int grp = gvalid ? grp0 : 0;
        __syncthreads();
        if (F.tid < 32) lcnt[F.tid] = 0u;
        __syncthreads();
        const int tok0 = grp * 16;
        const bf16_t* xr = X1b + (size_t)(tok0 + l15) * DM + 8 * g4;
        f32x4 acc[3];
#pragma unroll
        for (int j = 0; j < 3; ++j) acc[j] = (f32x4){0.f, 0.f, 0.f, 0.f};
        float ss = 0.f;
        LAS unsigned char* wl = F.lds + 32768;
#pragma unroll 1
        for (int half = 0; half < 2; ++half) {
            u32x4 xa[16];
#pragma unroll
            for (int ks = 0; ks < 16; ++ks) xa[ks] = *(const u32x4*)(xr + 512 * half + 32 * ks);
            __syncthreads();
            for (int idx = F.tid; idx < 72 * 64; idx += NWAVES * 64) { const int row = idx >> 6, c = idx & 63;
                const bf16_t* src = (row < 36 ? RH + (size_t)row * DM : RL + (size_t)(row - 36) * DM) + 512 * half + 8 * c;
                *(LAS u32x4*)(wl + row * 1040 + c * 16) = *(const u32x4*)src; }
            __syncthreads();
#pragma unroll
            for (int ks = 0; ks < 16; ++ks) {
                const u32x4 xw = xa[ks];
                { const float a0 = bflo(xw.x), a1 = bfhi(xw.x), a2 = bflo(xw.y), a3 = bfhi(xw.y), a4 = bflo(xw.z), a5 = bfhi(xw.z), a6 = bflo(xw.w), a7 = bfhi(xw.w);
                  ss += (a0 * a0 + a1 * a1) + (a2 * a2 + a3 * a3) + (a4 * a4 + a5 * a5) + (a6 * a6 + a7 * a7); }
                const bf16x8 ah = __builtin_bit_cast(bf16x8, xw);
#pragma unroll
                for (int j = 0; j < 3; ++j) {
                    const bf16x8 bh = *(const LAS bf16x8*)(wl + (16 * j + l15) * 1040 + 64 * ks + 16 * g4), bl = *(const LAS bf16x8*)(wl + (36 + 16 * j + l15) * 1040 + 64 * ks + 16 * g4);
                    acc[j] = __builtin_amdgcn_mfma_f32_16x16x32_bf16(ah, bh, acc[j], 0, 0, 0);
                    acc[j] = __builtin_amdgcn_mfma_f32_16x16x32_bf16(ah, bl, acc[j], 0, 0, 0);
                }
            }
        }
        ss += __shfl_xor(ss, 16); ss += __shfl_xor(ss, 32);
#pragma unroll
        for (int j = 0; j < 3; ++j)
#pragma unroll
            for (int rg = 0; rg < 4; ++rg) lg[(4 * g4 + rg) * 48 + 16 * j + l15] = acc[j][rg];
        asm volatile("s_waitcnt lgkmcnt(0)" ::: "memory");
        int E0 = 0, E1 = 0, r0 = 0, r1 = 0; float rstd = 0.f, cw0 = 0.f, cw1 = 0.f;
        const bool act = gvalid && lane < 16;
        if (act) {
            rstd = 1.0f / sqrtf(ss * (1.f / DM) + EPS);
            const LAS float* q = lg + lane * 48;
            float gl[4]; int gs = 0; float gmax;
#pragma unroll
            for (int g = 0; g < 4; ++g) gl[g] = q[g] * rstd + F.in[I_B_R1][g];
            gmax = gl[0];
#pragma unroll
            for (int g = 1; g < 4; ++g) if (gl[g] > gmax) { gmax = gl[g]; gs = g; }
            float den = 0.f;
#pragma unroll
            for (int g = 0; g < 4; ++g) den += __expf(gl[g] - gmax);
            const float pg = 1.0f / den;
            float el[8];
#pragma unroll
            for (int e = 0; e < 8; ++e) el[e] = q[4 + 8 * gs + e] * rstd + F.in[I_B_R2][gs * 8 + e];
            int i0 = 0; float v0 = el[0];
#pragma unroll
            for (int e = 1; e < 8; ++e) if (el[e] > v0) { v0 = el[e]; i0 = e; }
            int i1 = -1; float v1 = -__builtin_inff();
#pragma unroll
            for (int e = 0; e < 8; ++e) if (e != i0 && el[e] > v1) { v1 = el[e]; i1 = e; }
            const float w0 = 1.0f / (1.0f + __expf(v1 - v0));
            cw0 = w0 * pg; cw1 = (1.0f - w0) * pg;
            E0 = gs * 8 + i0; E1 = gs * 8 + i1;
            r0 = (int)__hip_atomic_fetch_add(lcnt + E0, 1u, __ATOMIC_RELAXED, __HIP_MEMORY_SCOPE_WORKGROUP);
            r1 = (int)__hip_atomic_fetch_add(lcnt + E1, 1u, __ATOMIC_RELAXED, __HIP_MEMORY_SCOPE_WORKGROUP);
        }
        __syncthreads();
        if (F.tid < 32) { const unsigned c = lcnt[F.tid]; lcnt[32 + F.tid] = c ? __hip_atomic_fetch_add(cnt + 64 * F.tid, c, __ATOMIC_RELAXED, __HIP_MEMORY_SCOPE_AGENT) : 0u; }
        __syncthreads();
        if (act && !F.dry) {
            const int tok = tok0 + lane; const int p0 = (int)lcnt[32 + E0] + r0, p1 = (int)lcnt[32 + E1] + r1;
            perm[(size_t)E0 * ECAP + p0] = tok; RSa[(size_t)E0 * ECAP + p0] = rstd; CWa[(size_t)E0 * ECAP + p0] = cw0;
            perm[(size_t)E1 * ECAP + p1] = tok; RSa[(size_t)E1 * ECAP + p1] = rstd; CWa[(size_t)E1 * ECAP + p1] = cw1;
            tokslot[2 * tok] = (E0 << 16) | p0; tokslot[2 * tok + 1] = (E1 << 16) | p1;
        }
        asm volatile("s_waitcnt lgkmcnt(0)" ::: "memory");
    }
}

constexpr int MOE_TB = MISC_OFF + 8192;
__device__ __forceinline__ void moe_tables(Frame& F) {
    LAS int* tb = (LAS int*)(F.lds + MOE_TB);
    __syncthreads();
    if (F.tid < 32) tb[64 + F.tid] = (int)F.ctl[CW_CNT + 64 * F.tid];
    __syncthreads();
    if (F.tid == 0) { int s = 0; for (int e = 0; e < 32; ++e) { tb[e] = s; s += (tb[64 + e] + 255) >> 8; } tb[32] = s; }
    __syncthreads();
}
struct MoeOrder {
    const LAS int* tb; const int* perm; int npn, G, c;
    __device__ __forceinline__ bool next(int i, pg8::Unit& u) const {
        const int U = tb[32] * npn; int L;
        if ((G & 7) == 0) { const int x = c & 7, j = c >> 3, per = G >> 3, q = U >> 3, r = U & 7; const int start = x * q + (x < r ? x : r), len = q + (x < r ? 1 : 0); const int li = j + per * i; if (li >= len) return false; L = start + li; }
        else { L = i * G + c; if (L >= U) return false; }
        const int tau = L / npn, pn = L % npn; int e = 0;
        for (int k = 1; k < 32; ++k) if (tb[k] <= tau) e = k;
        u.pm = __builtin_amdgcn_readfirstlane(tau); u.pn = __builtin_amdgcn_readfirstlane(pn); u.e = __builtin_amdgcn_readfirstlane(e); u.pb = u.e * npn + u.pn;
        u.r0 = __builtin_amdgcn_readfirstlane((tau - tb[e]) * 256); u.ne = __builtin_amdgcn_readfirstlane(tb[64 + e]); return true;
    }
    __device__ __forceinline__ int arow(const pg8::Unit& u, int r) const { const int pos = u.r0 + r; return perm[(size_t)u.e * ECAP + (pos < u.ne ? pos : 0)]; }
};

struct PleFillOrder {
    const LAS int* tb; int G, c;
    __device__ __forceinline__ bool next(int i, pg8::Unit& u) const {
        int L;
        if ((G & 7) == 0) { const int x = c & 7, j = c >> 3, per = G >> 3; const int U = tb[32] * 2, q = U >> 3, r = U & 7, len = q + (x < r ? 1 : 0);
            int hx = len - 2 * per; hx = hx < 0 ? 0 : (hx > per - 1 ? per - 1 : hx);
            if (j < hx) return false;
            const int li = (j - hx) + (per - hx) * i; if (li >= 64) return false; L = x * 64 + li; }
        else { L = i * G + c; if (L >= 512) return false; }
        u.pm = __builtin_amdgcn_readfirstlane(L >> 2); u.pn = __builtin_amdgcn_readfirstlane(L & 3); u.pb = u.pn; u.e = 0; u.r0 = 0; u.ne = 0; return true;
    }
    __device__ __forceinline__ int arow(const pg8::Unit& u, int r) const { return u.pm * pg8::BM + r; }
};

__device__ __forceinline__ void p11_combine(Frame& F) {
    const int lane = F.lane; const LAS int* tb = (const LAS int*)(F.lds + MOE_TB);
    bf16_t* XB = (bf16_t*)(F.ws + WS_A); const bf16_t* Y = (const bf16_t*)(F.ws + WS_Y); const int* tokslot = (const int*)(F.ws + S_TOKSLOT);
    float* R3 = (float*)(F.ws + S_RSTD3);
    const int NGW = F.G * NWAVES;
    for (int m0 = F.vcu * NWAVES + F.wave; m0 < NTOK; m0 += 2 * NGW) {
        u32x4 xv[2][2], ya[2][2], yb[2][2];
#pragma unroll
        for (int u = 0; u < 2; ++u) { const int m = (m0 + u * NGW < NTOK) ? m0 + u * NGW : m0;
            const int s0 = tokslot[2 * m], s1 = tokslot[2 * m + 1];
            const size_t r0 = (size_t)tb[s0 >> 16] * 256 + (s0 & 0xffff), r1 = (size_t)tb[s1 >> 16] * 256 + (s1 & 0xffff);
            const u32x4* xr = (const u32x4*)(XB + (size_t)m * DM) + lane; const u32x4* y0 = (const u32x4*)(Y + r0 * DM) + lane; const u32x4* y1 = (const u32x4*)(Y + r1 * DM) + lane;
#pragma unroll
            for (int j = 0; j < 2; ++j) { xv[u][j] = xr[64 * j]; ya[u][j] = y0[64 * j]; yb[u][j] = y1[64 * j]; } }
#pragma unroll
        for (int u = 0; u < 2; ++u) { const int m = m0 + u * NGW; if (m < NTOK) {
            u32x4* xo = (u32x4*)(XB + (size_t)m * DM) + lane;
            float s = 0.f;
#pragma unroll
            for (int j = 0; j < 2; ++j) { const unsigned xw[4] = {xv[u][j].x, xv[u][j].y, xv[u][j].z, xv[u][j].w}, aw[4] = {ya[u][j].x, ya[u][j].y, ya[u][j].z, ya[u][j].w}, bw[4] = {yb[u][j].x, yb[u][j].y, yb[u][j].z, yb[u][j].w};
                unsigned ow[4];
#pragma unroll
                for (int q = 0; q < 4; ++q) { const float lo = bflo(xw[q]) + bflo(aw[q]) + bflo(bw[q]), hi = bfhi(xw[q]) + bfhi(aw[q]) + bfhi(bw[q]); s += lo * lo + hi * hi; ow[q] = pk2(lo, hi); }
                xo[64 * j] = (u32x4){ow[0], ow[1], ow[2], ow[3]}; }
            s = wave_sum(s);
            if (lane == 0) R3[m] = 1.0f / sqrtf(s * (1.f / DM) + EPS); } }
    }
}
__device__ __forceinline__ void p14_final(Frame& F) {
    const int lane = F.lane;
    f32x4 gn[4];
#pragma unroll
    for (int j = 0; j < 4; ++j) gn[j] = *(const f32x4*)(F.in[I_FINAL_NORM] + 4 * lane + 256 * j);
    const int NGW = F.G * NWAVES;
    for (int m0 = F.vcu * NWAVES + F.wave; m0 < NTOK; m0 += 2 * NGW) {
        f32x4 v[2][4];
#pragma unroll
        for (int u = 0; u < 2; ++u) { const int m = (m0 + u * NGW < NTOK) ? m0 + u * NGW : m0; const f32x4* xr = (const f32x4*)(F.out + (size_t)m * DM) + lane;
#pragma unroll
            for (int j = 0; j < 4; ++j) v[u][j] = xr[64 * j]; }
#pragma unroll
        for (int u = 0; u < 2; ++u) { const int m = m0 + u * NGW; if (m < NTOK) { f32x4* xr = (f32x4*)(F.out + (size_t)m * DM) + lane; float s = 0.f;
#pragma unroll
            for (int j = 0; j < 4; ++j) s += (v[u][j][0] * v[u][j][0] + v[u][j][1] * v[u][j][1]) + (v[u][j][2] * v[u][j][2] + v[u][j][3] * v[u][j][3]);
            const float rstd = 1.0f / sqrtf(wave_sum(s) * (1.f / DM) + EPS);
#pragma unroll
            for (int j = 0; j < 4; ++j) if (!F.dry) xr[64 * j] = v[u][j] * rstd * gn[j]; } }
    }
}

#ifndef MK_PER_PHASE
#define MK_PER_PHASE 0
#endif
constexpr int NPHASE = 14;
struct Args { const float* in[23]; float* out; unsigned char* ws; int ph_lo, ph_hi, dry, pad; };
__global__ void __launch_bounds__(NWAVES * 64, 2) fwd(Args args) {
    extern __shared__ __attribute__((aligned(16))) unsigned char lds[];
    Frame F;
    F.lds = (LAS unsigned char*)lds;
    F.tid = threadIdx.x; F.lane = F.tid & 63; F.wave = __builtin_amdgcn_readfirstlane(F.tid >> 6);
    F.G = gridDim.x; { const int bx = blockIdx.x; F.vcu = (F.G % 8 == 0) ? (bx % 8) * (F.G / 8) + bx / 8 : bx; }
    F.ws = args.ws; F.ctl = (unsigned*)(args.ws + WS_CTL); F.out = args.out; F.dry = 0;
#pragma unroll
    for (int i = 0; i < 23; ++i) F.in[i] = args.in[i];
    volatile LAS unsigned* MISC = (volatile LAS unsigned*)(F.lds + MISC_OFF);
    if (F.tid < 16) MISC[F.tid] = 0u;
    __syncthreads();
    XcdBarrier bar; bar.bar = F.ctl + CW_BAR; bar.x = 0; bar.st = MISC;
    if (!MK_PER_PHASE) bar = xcd_barrier_post(F.ctl + CW_BAR, MISC);
    const int lo = args.ph_lo, hi = args.ph_hi;
#ifndef PH_MASK
#define PH_MASK 0x7fff
#endif
#define IN(k) (((PH_MASK >> (k)) & 1) && lo <= (k) && (k) < hi)
#define SEAM(k) do { if (IN((k) + 1)) xcd_barrier(bar); } while (0)
#ifdef PROBE_PH
#define PROBE(k, body) do { if (PROBE_PH == (k)) { F.dry = args.dry; body; xcd_barrier(bar); F.dry = 0; } } while (0)
#else
#define PROBE(k, body) do { } while (0)
#endif
    unsigned char* ws = args.ws;
    const int bx = (int)blockIdx.x;
    LAS unsigned char* ring = F.lds;

    if (IN(0)) { PROBE(0, p0_prologue(F)); p0_prologue(F); SEAM(0); }
    if (IN(1)) {
        pg8::Gemm g{(const bf16_t*)(ws + WS_H), (const bf16_t*)(ws + W_IN), DM, DM}; pg8::StaticOrder S; S.init(NTOK, NPROJ, F.G, bx);
        pg8::EpiProj E{(bf16_t*)(ws + WS_A), (bf16_t*)(ws + WS_G), ws + S_KIDX};
        PROBE(1, (pg8::gemm_phase<pg8::EpiProj, pg8::StaticOrder, false>(ring, g, S, E)));
        pg8::gemm_phase<pg8::EpiProj, pg8::StaticOrder, false>(ring, g, S, E); SEAM(1); }
    if (IN(2)) { p1b_extract(F); }
    if (IN(3)) { PROBE(3, p2_indexer(F)); p2_indexer(F); SEAM(3); }
    if (IN(4)) { PROBE(4, p3_sparse_attn(F)); PROBE(15, p4_stickbreak(F)); p3_sparse_attn(F); __syncthreads(); p0b_late_weights(F); __syncthreads(); p4_stickbreak(F); SEAM(4); }
    if (IN(5)) {
        pg8::Gemm g{(const bf16_t*)(ws + WS_A) + CA_QABS, (const bf16_t*)(ws + W_COMB), LDA, DM}; pg8::StaticOrder S; S.init(NTOK, DM, F.G, bx);
        pg8::EpiGate<false> E{(const bf16_t*)(ws + WS_G), 0, (bf16_t*)(ws + WS_H)};
        PROBE(5, (pg8::gemm_phase<pg8::EpiGate<false>, pg8::StaticOrder, false>(ring, g, S, E)));
        pg8::gemm_phase<pg8::EpiGate<false>, pg8::StaticOrder, false>(ring, g, S, E); }
    if (IN(6)) {
        pg8::Gemm g{(const bf16_t*)(ws + WS_A) + CA_QB, (const bf16_t*)(ws + W_BB), LDA, 512}; pg8::StaticOrder S; S.init(NTOK, DM, F.G, bx);
        pg8::EpiGate<true> E{(const bf16_t*)(ws + WS_G), 1024, (bf16_t*)(ws + WS_H)};
        pg8::gemm_phase<pg8::EpiGate<true>, pg8::StaticOrder, false>(ring, g, S, E); SEAM(6); }
    if (IN(7)) {
        pg8::Gemm g{(const bf16_t*)(ws + WS_H), (const bf16_t*)(ws + W_OUT), DM, DM}; pg8::StaticOrder S; S.init(NTOK, DM, F.G, bx);
        pg8::EpiResid E{F.in[I_X], (bf16_t*)(ws + WS_A)};
        PROBE(7, (pg8::gemm_phase<pg8::EpiResid, pg8::StaticOrder, false>(ring, g, S, E)));
        pg8::gemm_phase<pg8::EpiResid, pg8::StaticOrder, false>(ring, g, S, E); SEAM(7); }
    if (IN(8)) { PROBE(8, p8_router(F)); p8_router(F); SEAM(8); }
    if (IN(9)) {
        moe_tables(F);
        pg8::Gemm g{(const bf16_t*)(ws + WS_A), (const bf16_t*)(ws + W_GU), DM, DM};
        MoeOrder S{(const LAS int*)(F.lds + MOE_TB), (const int*)(ws + S_PERM), 2, F.G, bx};
        pg8::EpiMoeUp E{(const float*)(ws + S_RS), (const float*)(ws + S_CW), (bf16_t*)(ws + WS_H)};
        PROBE(9, (pg8::gemm_phase<pg8::EpiMoeUp, MoeOrder, true>(ring, g, S, E)));
        pg8::gemm_phase<pg8::EpiMoeUp, MoeOrder, true>(ring, g, S, E);
        {
            pg8::Gemm g2{(const bf16_t*)(ws + WS_PB), (const bf16_t*)(ws + W_PLE), 256, 256};
            PleFillOrder S2{(const LAS int*)(F.lds + MOE_TB), F.G, bx};
            pg8::EpiBf16 E2{(bf16_t*)(ws + WS_G), DM};
            pg8::gemm_phase<pg8::EpiBf16, PleFillOrder, false>(ring, g2, S2, E2); }
        SEAM(9); }
    if (IN(10)) {
        moe_tables(F);
        pg8::Gemm g{(const bf16_t*)(ws + WS_H), (const bf16_t*)(ws + W_DN), DEXP, DEXP};
        MoeOrder S{(const LAS int*)(F.lds + MOE_TB), (const int*)(ws + S_PERM), 4, F.G, bx};
        pg8::EpiBf16 E{(bf16_t*)(ws + WS_Y), DM};
        PROBE(10, (pg8::gemm_phase<pg8::EpiBf16, MoeOrder, false>(ring, g, S, E)));
        pg8::gemm_phase<pg8::EpiBf16, MoeOrder, false>(ring, g, S, E); SEAM(10); }
    if (IN(11)) { moe_tables(F); PROBE(11, p11_combine(F)); p11_combine(F); SEAM(11); }
    if (IN(13)) {
        pg8::Gemm g{(const bf16_t*)(ws + WS_A), (const bf16_t*)(ws + W_PG), DM, DM}; pg8::StaticOrder S; S.init(NTOK, DM, F.G, bx);
        pg8::EpiPleFinal E{F.out, (const bf16_t*)(ws + WS_A), (const bf16_t*)(ws + WS_G), (const float*)(ws + S_RSTD3), F.in[I_FINAL_NORM], (float*)(ws + S_PART), F.ctl + CW_PANEL, (LAS float*)(F.lds + MISC_OFF + 8192)};
        pg8::gemm_phase<pg8::EpiPleFinal, pg8::StaticOrder, false>(ring, g, S, E); }
#undef IN
#undef SEAM
}

extern "C" void kernel_launch(void* const* d_in, const int* in_sizes, int n_in, void* d_out, int out_size, void* d_ws, size_t ws_size, hipStream_t stream) {
    static int grid = 0;
    if (grid == 0) {
        if (n_in != 23 || out_size != NTOK * DM || ws_size < WS_END) { fprintf(stderr, "kernel_launch: unexpected shapes (n_in %d out %d ws %zu)\n", n_in, out_size, ws_size); grid = -1; return; }
        int dev = 0, cus = 0, per_cu = 0;
        if (hipGetDevice(&dev) != hipSuccess || hipDeviceGetAttribute(&cus, hipDeviceAttributeMultiprocessorCount, dev) != hipSuccess) { grid = -1; return; }
        if (hipFuncSetAttribute((const void*)fwd, hipFuncAttributeMaxDynamicSharedMemorySize, LDS_BYTES) != hipSuccess) { fprintf(stderr, "kernel_launch: hipFuncSetAttribute failed\n"); grid = -1; return; }
        if (hipOccupancyMaxActiveBlocksPerMultiprocessor(&per_cu, (const void*)fwd, NWAVES * 64, LDS_BYTES) != hipSuccess || per_cu < 1) fprintf(stderr, "kernel_launch: occupancy query says %d\n", per_cu);
        (void)hipGetLastError();
        grid = cus;
    }
    if (grid < 0) return;
    (void)hipMemsetAsync((char*)d_ws + WS_CTL, 0, CTL_ZERO_BYTES, stream);
    Args a{};
    for (int i = 0; i < 23; ++i) a.in[i] = (const float*)d_in[i];
    a.out = (float*)d_out; a.ws = (unsigned char*)d_ws; a.dry = 1;
#if MK_PER_PHASE
    for (int p = 0; p < NPHASE; ++p) { a.ph_lo = p; a.ph_hi = p + 1; hipLaunchKernelGGL(fwd, dim3(grid), dim3(NWAVES * 64), LDS_BYTES, stream, a); }
#else
    a.ph_lo = 0; a.ph_hi = NPHASE; hipLaunchKernelGGL(fwd, dim3(grid), dim3(NWAVES * 64), LDS_BYTES, stream, a);
#endif
}
```

```cpp
#include <hip/hip_runtime.h>
#include <cstdio>
#include <cstdint>

#define GAS __attribute__((address_space(1)))
#define LAS __attribute__((address_space(3)))
typedef unsigned short bf16_t;
typedef short bf16x8 __attribute__((ext_vector_type(8)));
typedef short s16x4 __attribute__((ext_vector_type(4)));
typedef float f32x4 __attribute__((ext_vector_type(4)));
typedef float f32x16 __attribute__((ext_vector_type(16)));
typedef float f32x2 __attribute__((ext_vector_type(2)));
typedef unsigned u32x4 __attribute__((ext_vector_type(4)));
typedef unsigned u32x2 __attribute__((ext_vector_type(2)));
typedef short v4i16_t __attribute__((ext_vector_type(4)));

constexpr int NB = 16, SEQ = 2048, DM = 1024, NTOK = NB * SEQ;
constexpr int LDA = 3328, LDG = 2048;
constexpr int CA_QABS = 0, CA_CKV = 1024, CA_KIDX = 1152, CA_WIDX = 1216, CA_QIDX = 1280, CA_QB = 1792, CA_KB = 2304, CA_VB = 2816;
constexpr int NPROJ = LDA + LDG;
constexpr int NEXP = 32, DEXP = 256, ECAP = NTOK;
constexpr int MAXT = NTOK * 2 / 256 + NEXP;
constexpr float EPS = 1e-6f;

constexpr size_t MiB = 1u << 20;
constexpr size_t WS_CTL = 0, CTL_ZERO_BYTES = 1 * MiB;
constexpr size_t WS_W = 1 * MiB;
constexpr size_t W_IN = WS_W;
constexpr size_t W_COMB = W_IN + (size_t)NPROJ * DM * 2;
constexpr size_t W_BB = W_COMB + 2 * MiB;
constexpr size_t W_OUT = W_BB + 1 * MiB;
constexpr size_t W_GU = W_OUT + 2 * MiB;
constexpr size_t W_DN = W_GU + 32 * MiB;
constexpr size_t W_PG = W_DN + 16 * MiB;
constexpr size_t W_PLE = W_PG + 2 * MiB;
constexpr size_t W_RHI = W_PLE + MiB / 2;
constexpr size_t W_RLO = W_RHI + 128 * 1024;
constexpr size_t W_END = W_RLO + 128 * 1024;
static_assert(W_END <= 68 * MiB, "weights region");
constexpr size_t WS_PB = 68 * MiB;
constexpr size_t WS_H = 84 * MiB;
constexpr size_t WS_A = 148 * MiB;
constexpr size_t WS_Y = WS_A + 64 * MiB;
constexpr size_t WS_G = 356 * MiB;
constexpr size_t WS_S = 484 * MiB;
constexpr size_t S_CKVN = WS_S, S_KIDX = WS_S + 8 * MiB, S_SEL = WS_S + 12 * MiB;
constexpr size_t S_PERM = WS_S, S_RS = WS_S + 4 * MiB, S_CW = WS_S + 8 * MiB, S_TOKSLOT = WS_S + 12 * MiB, S_RSTD3 = WS_S + 13 * MiB, S_PART = WS_S + 14 * MiB;
constexpr size_t WS_END = 512 * MiB;
constexpr int CW_BAR = 4096;
constexpr int CW_CNT = 16384;
constexpr int CW_PANEL = 65536;
constexpr int RING_BYTES = 131072;
constexpr int MISC_OFF = RING_BYTES;
constexpr int LDS_BYTES = 147456;
constexpr int NWAVES = 8;

#define VM_WAIT() asm volatile("s_waitcnt vmcnt(0)" ::: "memory")
#define LDS_WAIT() asm volatile("s_waitcnt lgkmcnt(0)" ::: "memory")

__device__ __forceinline__ unsigned f2bf(float f) { unsigned u = __builtin_bit_cast(unsigned, f); return (u + 0x7fffu + ((u >> 16) & 1u)) >> 16; }
__device__ __forceinline__ unsigned pk2(float lo, float hi) { return f2bf(lo) | (f2bf(hi) << 16); }
__device__ __forceinline__ float bf2f(unsigned short b) { return __builtin_bit_cast(float, ((unsigned)b) << 16); }
__device__ __forceinline__ float bflo(unsigned w) { return __builtin_bit_cast(float, w << 16); }
__device__ __forceinline__ float bfhi(unsigned w) { return __builtin_bit_cast(float, w & 0xffff0000u); }
__device__ __forceinline__ unsigned cvt_pk_bf16(float lo, float hi) { unsigned r; asm volatile("v_cvt_pk_bf16_f32 %0, %1, %2" : "=v"(r) : "v"(lo), "v"(hi)); return r; }
#define GAS __attribute__((address_space(1)))
template <class T> __device__ __forceinline__ T gld(const void* p) { return *(const GAS T*)p; }
template <class T> __device__ __forceinline__ void gst(void* p, const T& v) { *(GAS T*)p = v; }
__device__ __forceinline__ float fast_exp(float x) { return __builtin_amdgcn_exp2f(x * 1.44269504089f); }
__device__ __forceinline__ float sigmoidf_(float x) { return __builtin_amdgcn_rcpf(1.0f + fast_exp(-x)); }
__device__ __forceinline__ float wave_sum(float v) {
#pragma unroll
    for (int o = 1; o < 64; o <<= 1) v += __shfl_xor(v, o);
    return v;
}

#define XB_TMO      128
#define XB_XCNT(j)  (256  + 64 * (j))
#define XB_XSUB(j)  (1280 + 64 * (j))
#define XB_XGEN(j)  (2304 + 64 * (j))
#define XB_TOP      3328
#define XB_TOPGEN   3392
#define XCD_BAR_WORDS 3456
#define XB_SPIN_CAP (1u << 18)
__device__ __forceinline__ unsigned xb_ld(unsigned* p)              { return __hip_atomic_load(p, __ATOMIC_RELAXED, __HIP_MEMORY_SCOPE_AGENT); }
__device__ __forceinline__ unsigned xb_add(unsigned* p, unsigned v) { return __hip_atomic_fetch_add(p, v, __ATOMIC_RELAXED, __HIP_MEMORY_SCOPE_AGENT); }
__device__ __forceinline__ unsigned xb_xcc_id() { return (unsigned)__builtin_amdgcn_s_getreg((3 << 11) | 20) & 0xFu; }
#define XB_SPIN(cond, bar) do { unsigned _sp = 0; while (cond) { __builtin_amdgcn_s_sleep(1); \
    if ((++_sp & 255u) == 0u) { if (xb_ld(&(bar)[XB_TMO])) break; if (_sp > XB_SPIN_CAP) { atomicAdd(&(bar)[XB_TMO], 1u); break; } } } } while (0)
struct XcdBarrier { unsigned* bar; unsigned x; volatile LAS unsigned* st; };
__device__ __forceinline__ XcdBarrier xcd_barrier_post(unsigned* bar, volatile LAS unsigned* st) {
    XcdBarrier b; b.bar = bar; b.x = xb_xcc_id(); b.st = st;
    if (threadIdx.x == 0) (void)xb_add(&bar[XB_XCNT(b.x)], 1u);
    return b;
}
__device__ __forceinline__ void xcd_barrier_complete(unsigned* bar, unsigned x, unsigned& nloc, unsigned& nx) {
    const unsigned G = gridDim.x * gridDim.y * gridDim.z;
    unsigned sum, cnt, mine, sp = 0u;
    for (;;) {
        sum = 0u; cnt = 0u; mine = 0u;
#pragma unroll
        for (unsigned j = 0; j < 16; ++j) { const unsigned c = xb_ld(&bar[XB_XCNT(j)]); sum += c; cnt += (c > 0u) ? 1u : 0u; mine = (j == x) ? c : mine; }
        if (sum == G) break;
        __builtin_amdgcn_s_sleep(1);
        if ((++sp & 255u) == 0u) { if (xb_ld(&bar[XB_TMO])) break; if (sp > XB_SPIN_CAP) { atomicAdd(&bar[XB_TMO], 1u); break; } }
    }
    nloc = mine > 0u ? mine : 1u; nx = cnt > 0u ? cnt : 1u;
}
__device__ __forceinline__ void xcd_barrier(const XcdBarrier& b) {
    asm volatile("s_waitcnt vmcnt(0)" ::: "memory");
    __syncthreads();
    if (threadIdx.x == 0) {
        unsigned* bar = b.bar;
        __builtin_amdgcn_s_waitcnt(0);
        unsigned nloc = b.st[0], nx = b.st[1];
        if (nloc == 0u) { xcd_barrier_complete(bar, b.x, nloc, nx); b.st[0] = nloc; b.st[1] = nx; }
        const unsigned old = xb_add(&bar[XB_XSUB(b.x)], 1u);
        const unsigned gen = old / nloc;
        if (old + 1u == (gen + 1u) * nloc) {
            __builtin_amdgcn_fence(__ATOMIC_RELEASE, "agent");
            asm volatile("s_waitcnt vmcnt(0)" ::: "memory");
            const unsigned og = xb_add(&bar[XB_TOP], 1u);
            const unsigned tg = og / nx;
            if (og + 1u == (tg + 1u) * nx) xb_add(&bar[XB_TOPGEN], 1u);
            else XB_SPIN(xb_ld(&bar[XB_TOPGEN]) == tg, bar);
            __builtin_amdgcn_fence(__ATOMIC_ACQUIRE, "agent");
            xb_add(&bar[XB_XGEN(b.x)], 1u);
            asm volatile("s_waitcnt vmcnt(0)" ::: "memory");
        } else {
            XB_SPIN(xb_ld(&bar[XB_XGEN(b.x)]) == gen, bar);
            __builtin_amdgcn_fence(__ATOMIC_ACQUIRE, "agent");
            asm volatile("s_waitcnt vmcnt(0)" ::: "memory");
        }
    }
    __syncthreads();
}

namespace pg8 {
constexpr int BM = 256, BK = 64, HALF = 128, HTB = HALF * BK * 2, STAGE_BYTES = 8 * HTB, NXCD = 8;
__host__ __device__ __forceinline__ int lds_byte(int r, int c) { const int st = (r >> 4) * 2 + (c >> 5), rr = r & 15, cc = c & 31, ob = rr * 64 + cc * 2; return st * 1024 + (ob ^ (((ob >> 9) & 1) << 5)); }
__host__ __device__ __forceinline__ void stage_rc(int b, int& R, int& C) { const int st = b / 1024, sb = b % 1024, swz = sb ^ (((sb >> 9) & 1) << 5); R = (st >> 1) * 16 + swz / 64; C = (st & 1) * 32 + (swz % 64) / 2; }
__host__ __device__ __forceinline__ int perm32(int rho) { const int n = rho >> 4, i = rho & 15; return 8 * (i >> 2) + 4 * n + (i & 3); }

struct Unit { int pm, pn, pb, e, r0, ne; };
struct Gemm { const bf16_t* A; const bf16_t* Bt; int lda; int K; };

struct StaticOrder {
    int nN, nwg, G, c;
    __device__ void init(int M, int N, int G_, int c_) { nN = N / BM; nwg = (M / BM) * nN; G = G_; c = c_; }
    __device__ __forceinline__ bool next(int i, Unit& u) const {
        int L;
        if ((G & 7) == 0) { const int x = c & 7, j = c >> 3, per = G >> 3, q = nwg >> 3, r = nwg & 7; const int start = x * q + (x < r ? x : r), len = q + (x < r ? 1 : 0); const int li = j + per * i; if (li >= len) return false; L = start + li; }
        else { L = i * G + c; if (L >= nwg) return false; }
        const int nM = nwg / nN, nig = 8 * nN, gid = L / nig, fm = gid * 8, gsz = (nM - fm) < 8 ? (nM - fm) : 8;
        u.pm = fm + ((L % nig) % gsz); u.pn = (L % nig) / gsz; u.pb = u.pn; u.e = 0; u.r0 = 0; u.ne = 0; return true;
    }
    __device__ __forceinline__ int arow(const Unit& u, int r) const { return u.pm * BM + r; }
};

template <class Epi, class Sched, bool GATHER>
__device__ __forceinline__ void gemm_phase(LAS unsigned char* lds, const Gemm g, const Sched& S, const Epi& E) {
    const int tid = threadIdx.x, wid = __builtin_amdgcn_readfirstlane(tid >> 6), lane = tid & 63, wr = wid >> 2, wc = wid & 3, fr = lane & 15, fq = lane >> 4;
    const int K = g.K, nt = K / BK, lda = g.lda;
    unsigned voffA[2], voffB[2]; int RA[2], CAo[2];
#pragma unroll
    for (int i = 0; i < 2; ++i) { int R, C; stage_rc(tid * 16 + i * 8192, R, C); const int Rb = Epi::PERM ? (64 * (R >> 5) + perm32(R & 31)) : R;
        RA[i] = R; CAo[i] = C * 2; voffA[i] = (unsigned)(R * lda + C) * 2u; voffB[i] = (unsigned)(Rb * K + C) * 2u; }
    unsigned vg[2][2] = {{0u, 0u}, {0u, 0u}};
    const size_t kstep = (size_t)(BK * 2);
    const size_t hstepA = (size_t)HALF * lda * 2, tstepA = 2 * hstepA;
    const size_t hstepB = (size_t)(Epi::PERM ? 32 : HALF) * K * 2, tstepB = (size_t)BM * K * 2;
    const unsigned ldsw = (unsigned)wid * 1024u;
    const int aoff = lds_byte(wr * 64 + fr, fq * 8), boff = lds_byte(wc * 32 + fr, fq * 8);
#define PG8_SA(b, h) (((b) * 2 + (h)) * HTB)
#define PG8_SB(b, h) ((4 + (b) * 2 + (h)) * HTB)
#define PG8_STAGE(bufoff, gbase, voff) do { _Pragma("unroll") for (int _i = 0; _i < 2; ++_i) \
        __builtin_amdgcn_global_load_lds((const unsigned*)((const char*)(gbase) + (voff)[_i]), (LAS unsigned*)(lds + (bufoff) + ldsw + _i * 8192), 16, 0, 0); } while (0)
#define PG8_STAGE_A(bufoff, aptr, h) do { if constexpr (GATHER) { PG8_STAGE(bufoff, (const char*)g.A + (size_t)(aptr), vg[h]); } else { PG8_STAGE(bufoff, (const char*)(aptr) + (h) * hstepA, voffA); } } while (0)
#define PG8_LOADVG(u) do { _Pragma("unroll") for (int _h = 0; _h < 2; ++_h) _Pragma("unroll") for (int _i = 0; _i < 2; ++_i) \
        vg[_h][_i] = (unsigned)S.arow(u, _h * HALF + RA[_i]) * (unsigned)(lda * 2) + (unsigned)CAo[_i]; } while (0)
#define PG8_LDA(dst, b, h) do { _Pragma("unroll") for (int m = 0; m < 4; ++m) _Pragma("unroll") for (int k = 0; k < 2; ++k) dst[m][k] = *(const LAS bf16x8*)(lds + PG8_SA(b, h) + aoff + m * 2048 + k * 1024); } while (0)
#define PG8_LDB(dst, b, h) do { _Pragma("unroll") for (int n = 0; n < 2; ++n) _Pragma("unroll") for (int k = 0; k < 2; ++k) dst[n][k] = *(const LAS bf16x8*)(lds + PG8_SB(b, h) + boff + n * 2048 + k * 1024); } while (0)
#define PG8_MMA(ai, bj, At, Bt) do { __builtin_amdgcn_s_setprio(1); _Pragma("unroll") for (int m = 0; m < 4; ++m) _Pragma("unroll") for (int n = 0; n < 2; ++n) _Pragma("unroll") for (int k = 0; k < 2; ++k) \
        acc[ai][bj][m][n] = __builtin_amdgcn_mfma_f32_16x16x32_bf16(Bt[n][k], At[m][k], acc[ai][bj][m][n], 0, 0, 0); __builtin_amdgcn_s_setprio(0); } while (0)
#define PG8_WAIT_V(n) asm volatile("s_waitcnt vmcnt(" #n ")" ::: "memory")
#define PG8_WAIT_L(n) asm volatile("s_waitcnt lgkmcnt(" #n ")" ::: "memory")
#define PG8_BAR __builtin_amdgcn_s_barrier()
#define PG8_SCHED __builtin_amdgcn_sched_barrier(0)
    Unit cur, nxt; int ui = 0;
    if (!S.next(0, cur)) return;
    f32x4 acc[2][2][4][2];
#pragma unroll
    for (int a = 0; a < 2; ++a)
#pragma unroll
        for (int b = 0; b < 2; ++b)
#pragma unroll
            for (int m = 0; m < 4; ++m)
#pragma unroll
                for (int n = 0; n < 2; ++n) acc[a][b][m][n] = (f32x4){0.f, 0.f, 0.f, 0.f};
    bf16x8 At[4][2], B0[2][2], B1[2][2];
    size_t cA = GATHER ? (size_t)0 : (size_t)((const char*)g.A + (size_t)cur.pm * tstepA);
    const char* cB = (const char*)g.Bt + (size_t)cur.pb * tstepB;
    if constexpr (GATHER) PG8_LOADVG(cur);
    PG8_STAGE(PG8_SB(0, 0), cB, voffB); PG8_STAGE(PG8_SB(0, 1), cB + hstepB, voffB); PG8_STAGE_A(PG8_SA(0, 0), cA, 0); PG8_STAGE_A(PG8_SA(0, 1), cA, 1);
    if (wr == 1) PG8_BAR;
    PG8_WAIT_V(2); PG8_BAR;
    PG8_STAGE(PG8_SB(1, 0), cB + kstep, voffB); PG8_STAGE_A(PG8_SA(1, 0), cA + kstep, 0); PG8_STAGE(PG8_SB(1, 1), cB + hstepB + kstep, voffB);
    PG8_WAIT_V(6); PG8_BAR;
    for (;;) {
        const bool has_next = S.next(ui + 1, nxt);
        const size_t nA = has_next ? (GATHER ? (size_t)0 : (size_t)((const char*)g.A + (size_t)nxt.pm * tstepA)) : cA;
        const char* nB = has_next ? (const char*)g.Bt + (size_t)nxt.pb * tstepB : cB;
        for (int t = 0; t < nt; t += 2) {
            const bool last = (t == nt - 2);
            const size_t a1 = cA + (size_t)(t + 1) * kstep;
            const size_t a2 = last ? nA : cA + (size_t)(t + 2) * kstep; const char* b2 = last ? nB : cB + (size_t)(t + 2) * kstep;
            const size_t a3 = a2 + kstep; const char* b3 = b2 + kstep;
            PG8_LDB(B0, 0, 0); PG8_LDB(B1, 0, 1); PG8_SCHED; PG8_LDA(At, 0, 0); PG8_STAGE_A(PG8_SA(1, 1), a1, 1);
            if constexpr (GATHER) { if (last && has_next) PG8_LOADVG(nxt); }
            PG8_WAIT_V(8); PG8_WAIT_L(0); PG8_BAR; PG8_MMA(0, 0, At, B0); PG8_MMA(0, 1, At, B1); PG8_BAR; PG8_SCHED;
            PG8_LDA(At, 0, 1); PG8_STAGE(PG8_SB(0, 0), b2, voffB); PG8_STAGE(PG8_SB(0, 1), b2 + hstepB, voffB); PG8_STAGE_A(PG8_SA(0, 0), a2, 0);
            PG8_WAIT_V(8); PG8_WAIT_L(0); PG8_BAR; PG8_MMA(1, 0, At, B0); PG8_MMA(1, 1, At, B1); PG8_BAR; PG8_SCHED;
            PG8_LDB(B0, 1, 0); PG8_LDB(B1, 1, 1); PG8_SCHED; PG8_LDA(At, 1, 0); PG8_STAGE_A(PG8_SA(0, 1), a2, 1);
            PG8_WAIT_V(8); PG8_WAIT_L(0); PG8_BAR; PG8_MMA(0, 0, At, B0); PG8_MMA(0, 1, At, B1); PG8_BAR; PG8_SCHED;
            PG8_LDA(At, 1, 1); PG8_STAGE(PG8_SB(1, 0), b3, voffB); PG8_STAGE(PG8_SB(1, 1), b3 + hstepB, voffB); PG8_STAGE_A(PG8_SA(1, 0), a3, 0);
            PG8_WAIT_V(8); PG8_WAIT_L(0); PG8_BAR; PG8_MMA(1, 0, At, B0); PG8_MMA(1, 1, At, B1); PG8_BAR; PG8_SCHED;
        }
        if (wr == 0) PG8_BAR;
        E(acc, cur, wr, wc, fr, fq, lds + PG8_SA(1, 1) + ldsw);
        if (!has_next) break;
#pragma unroll
        for (int a = 0; a < 2; ++a)
#pragma unroll
            for (int b = 0; b < 2; ++b)
#pragma unroll
                for (int m = 0; m < 4; ++m)
#pragma unroll
                    for (int n = 0; n < 2; ++n) acc[a][b][m][n] = (f32x4){0.f, 0.f, 0.f, 0.f};
        cur = nxt; cA = nA; cB = nB; ++ui;
        if (wr == 1) PG8_BAR;
    }
    PG8_WAIT_V(0);
    PG8_BAR;
#undef PG8_SA
#undef PG8_SB
#undef PG8_STAGE
#undef PG8_STAGE_A
#undef PG8_LOADVG
#undef PG8_LDA
#undef PG8_LDB
#undef PG8_MMA
#undef PG8_WAIT_V
#undef PG8_WAIT_L
#undef PG8_BAR
#undef PG8_SCHED
}

#define EPI_LOOP_ROWS for (int ai = 0; ai < 2; ++ai) _Pragma("unroll") for (int m = 0; m < 4; ++m)

__device__ __forceinline__ LAS u32x4* epi_frag(LAS unsigned char* scr, int fr, int ch) { return (LAS u32x4*)(scr + (fr >> 3) * 8192 + (fr & 7) * 128 + ((ch ^ (fr >> 1)) & 7) * 16); }
__device__ __forceinline__ LAS u32x4* epi_line(LAS unsigned char* scr, int i, int lane) { const int row = 8 * i + (lane >> 3); return (LAS u32x4*)(scr + i * 8192 + (lane >> 3) * 128 + (((lane & 7) ^ (row >> 1)) & 7) * 16); }
#define EPI_PK8(v0, v1) (u32x4){cvt_pk_bf16((v0)[0], (v0)[1]), cvt_pk_bf16((v0)[2], (v0)[3]), cvt_pk_bf16((v1)[0], (v1)[1]), cvt_pk_bf16((v1)[2], (v1)[3])}
struct EpiProj {
    static constexpr bool PERM = true;
    bf16_t* A; bf16_t* G; unsigned char* KF;
    __device__ __forceinline__ void operator()(const f32x4 (&acc)[2][2][4][2], const Unit& u, int wr, int wc, int fr, int fq, LAS unsigned char* scr) const {
        asm volatile("" : "+v"(fr), "+v"(fq));
        const int lane = fq * 16 + fr;
        bf16_t* base; int ldc, colt;
        if (u.pn < 13) { base = A; ldc = LDA; colt = u.pn * BM; } else { base = G; ldc = LDG; colt = (u.pn - 13) * BM; }
        bf16_t* op = base + (size_t)(u.pm * BM + wr * 64 + (lane >> 3)) * ldc + colt + wc * 64 + 8 * (lane & 7);
        LAS u32x4* f0 = epi_frag(scr, fr, fq); LAS u32x4* f1 = epi_frag(scr, fr, 4 + fq); LAS u32x4* l0 = epi_line(scr, 0, lane); LAS u32x4* l1 = epi_line(scr, 1, lane);
        const size_t st8 = (size_t)8 * ldc;
        const bool kf = (u.pn == CA_KIDX / BM) && wc == 2;
        const int grow0 = u.pm * BM + wr * 64 + fr;
#pragma unroll
        for (int ai = 0; ai < 2; ++ai) {
#pragma unroll
            for (int m = 0; m < 4; ++m) {
                asm volatile("" : "+v"(op));
                const u32x4 w0 = EPI_PK8(acc[ai][0][m][0], acc[ai][0][m][1]), w1 = EPI_PK8(acc[ai][1][m][0], acc[ai][1][m][1]);
                *f0 = w0; *f1 = w1;
                if (kf) { const int grow = grow0 + ai * HALF + m * 16; unsigned char* kp = KF + ((size_t)((grow >> 5) * 4 + (fq >> 1)) * 64 + (fq & 1) * 32 + (grow & 31)) * 16;
                    *(u32x4*)kp = w0; *(u32x4*)(kp + 2 * 1024) = w1; }
                const u32x4 r0 = *l0, r1 = *l1;
                gst<u32x4>(op, r0); gst<u32x4>(op + st8, r1);
                op += 2 * st8; }
            op += (size_t)(HALF - 64) * ldc; }
    }
};
struct EpiBf16 {
    static constexpr bool PERM = true;
    bf16_t* O; int ldc, cs;
    __device__ __forceinline__ void operator()(const f32x4 (&acc)[2][2][4][2], const Unit& u, int wr, int wc, int fr, int fq, LAS unsigned char* scr) const {
        asm volatile("" : "+v"(fr), "+v"(fq));
        const int lane = fq * 16 + fr;
        bf16_t* op = O + (size_t)(u.pm * BM + wr * 64 + (lane >> 3)) * ldc + u.pn * cs + wc * 64 + 8 * (lane & 7);
        LAS u32x4* f0 = epi_frag(scr, fr, fq); LAS u32x4* f1 = epi_frag(scr, fr, 4 + fq); LAS u32x4* l0 = epi_line(scr, 0, lane); LAS u32x4* l1 = epi_line(scr, 1, lane);
        const size_t st8 = (size_t)8 * ldc;
#pragma unroll
        for (int ai = 0; ai < 2; ++ai) {
#pragma unroll
            for (int m = 0; m < 4; ++m) {
                asm volatile("" : "+v"(op));
                { const f32x4 v0 = acc[ai][0][m][0], v1 = acc[ai][0][m][1]; u32x4 w; w.x = cvt_pk_bf16(v0[0], v0[1]); w.y = cvt_pk_bf16(v0[2], v0[3]); w.z = cvt_pk_bf16(v1[0], v1[1]); w.w = cvt_pk_bf16(v1[2], v1[3]); *f0 = w; }
                { const f32x4 v0 = acc[ai][1][m][0], v1 = acc[ai][1][m][1]; u32x4 w; w.x = cvt_pk_bf16(v0[0], v0[1]); w.y = cvt_pk_bf16(v0[2], v0[3]); w.z = cvt_pk_bf16(v1[0], v1[1]); w.w = cvt_pk_bf16(v1[2], v1[3]); *f1 = w; }
                const u32x4 w0 = *l0, w1 = *l1;
                gst<u32x4>(op, w0); gst<u32x4>(op + st8, w1);
                op += 2 * st8; }
            op += (size_t)(HALF - 64) * ldc; }
    }
};
template <bool ACCUM> struct EpiGate {
    static constexpr bool PERM = true;
    const bf16_t* Gt; int gcol; bf16_t* Mg;
    __device__ __forceinline__ void operator()(const f32x4 (&acc)[2][2][4][2], const Unit& u, int wr, int wc, int fr, int fq, LAS unsigned char* scr) const {
        asm volatile("" : "+v"(fr), "+v"(fq));
        const int lane = fq * 16 + fr;
        const int rowl = u.pm * BM + wr * 64 + (lane >> 3), coll = u.pn * BM + wc * 64 + 8 * (lane & 7);
        LAS u32x4* f0 = epi_frag(scr, fr, fq); LAS u32x4* f1 = epi_frag(scr, fr, 4 + fq); LAS u32x4* l0 = epi_line(scr, 0, lane); LAS u32x4* l1 = epi_line(scr, 1, lane);
#pragma unroll
        for (int ai = 0; ai < 2; ++ai) {
            u32x4 gl[4][2], pl[4][2];
#pragma unroll
            for (int m = 0; m < 4; ++m)
#pragma unroll
                for (int i = 0; i < 2; ++i) { const size_t r = (size_t)(rowl + ai * HALF + m * 16 + 8 * i);
                    gl[m][i] = *(const u32x4*)(Gt + r * LDG + gcol + coll);
                    if (ACCUM) pl[m][i] = *(const u32x4*)(Mg + r * DM + coll); }
            asm volatile("s_waitcnt vmcnt(0)" ::: "memory");
#pragma unroll
            for (int m = 0; m < 4; ++m) {
                *l0 = gl[m][0]; *l1 = gl[m][1];
                const u32x4 gq[2] = {*f0, *f1};
                u32x4 pq[2];
                if (ACCUM) { *l0 = pl[m][0]; *l1 = pl[m][1]; pq[0] = *f0; pq[1] = *f1; }
                u32x4 wq[2];
#pragma unroll
                for (int bj = 0; bj < 2; ++bj) { const f32x4 v0 = acc[ai][bj][m][0], v1 = acc[ai][bj][m][1]; const u32x4 g = gq[bj];
                    float o[8];
                    o[0] = sigmoidf_(bflo(g.x)) * v0[0]; o[1] = sigmoidf_(bfhi(g.x)) * v0[1]; o[2] = sigmoidf_(bflo(g.y)) * v0[2]; o[3] = sigmoidf_(bfhi(g.y)) * v0[3];
                    o[4] = sigmoidf_(bflo(g.z)) * v1[0]; o[5] = sigmoidf_(bfhi(g.z)) * v1[1]; o[6] = sigmoidf_(bflo(g.w)) * v1[2]; o[7] = sigmoidf_(bfhi(g.w)) * v1[3];
                    if (ACCUM) { const u32x4 p = pq[bj];
                        o[0] += bflo(p.x); o[1] += bfhi(p.x); o[2] += bflo(p.y); o[3] += bfhi(p.y); o[4] += bflo(p.z); o[5] += bfhi(p.z); o[6] += bflo(p.w); o[7] += bfhi(p.w); }
                    wq[bj].x = cvt_pk_bf16(o[0], o[1]); wq[bj].y = cvt_pk_bf16(o[2], o[3]); wq[bj].z = cvt_pk_bf16(o[4], o[5]); wq[bj].w = cvt_pk_bf16(o[6], o[7]); }
                *f0 = wq[0]; *f1 = wq[1];
                const u32x4 r0 = *l0, r1 = *l1;
                bf16_t* op = Mg + (size_t)(rowl + ai * HALF + m * 16) * DM + coll;
                *(u32x4*)op = r0; *(u32x4*)(op + 8 * DM) = r1; }
        }
    }
};
struct EpiResid {
    static constexpr bool PERM = true;
    const float* X; bf16_t* X1b;
    __device__ __forceinline__ void operator()(const f32x4 (&acc)[2][2][4][2], const Unit& u, int wr, int wc, int fr, int fq, LAS unsigned char* scr) const {
        asm volatile("" : "+v"(fr), "+v"(fq));
        const int lane = fq * 16 + fr;
        const int rowl = u.pm * BM + wr * 64 + (lane >> 3);
        const int colx = u.pn * BM + wc * 64 + 4 * (lane & 7);
        const int coll = u.pn * BM + wc * 64 + 8 * (lane & 7);
        LAS u32x4* f0 = epi_frag(scr, fr, fq); LAS u32x4* f1 = epi_frag(scr, fr, 4 + fq); LAS u32x4* l0 = epi_line(scr, 0, lane); LAS u32x4* l1 = epi_line(scr, 1, lane);
        LAS f32x4* c0 = (LAS f32x4*)epi_frag(scr, fr, 2 * fq); LAS f32x4* c1 = (LAS f32x4*)epi_frag(scr, fr, 2 * fq + 1);
#pragma unroll
        for (int ai = 0; ai < 2; ++ai) {
            f32x4 xl[4][2][2];
#pragma unroll
            for (int m = 0; m < 4; ++m)
#pragma unroll
                for (int bj = 0; bj < 2; ++bj)
#pragma unroll
                    for (int i = 0; i < 2; ++i) xl[m][bj][i] = *(const f32x4*)(X + (size_t)(rowl + ai * HALF + m * 16 + 8 * i) * DM + colx + bj * 32);
            asm volatile("s_waitcnt vmcnt(0)" ::: "memory");
#pragma unroll
            for (int m = 0; m < 4; ++m) {
                u32x4 wq[2];
#pragma unroll
                for (int bj = 0; bj < 2; ++bj) { *(LAS f32x4*)l0 = xl[m][bj][0]; *(LAS f32x4*)l1 = xl[m][bj][1];
                    const f32x4 v0 = acc[ai][bj][m][0] + *c0, v1 = acc[ai][bj][m][1] + *c1;
                    wq[bj] = EPI_PK8(v0, v1); }
                *f0 = wq[0]; *f1 = wq[1];
                const u32x4 r0 = *l0, r1 = *l1;
                bf16_t* op = X1b + (size_t)(rowl + ai * HALF + m * 16) * DM + coll;
                *(u32x4*)op = r0; *(u32x4*)(op + 8 * DM) = r1; }
        }
    }
};
struct EpiMoeUp {
    static constexpr bool PERM = true;
    const float* RS; const float* CW; bf16_t* Act;
    __device__ __forceinline__ void operator()(const f32x4 (&acc)[2][2][4][2], const Unit& u, int wr, int wc, int fr, int fq, LAS unsigned char* scr) const {
        const int rl0 = wr * 64 + fr, colh = (u.pn * BM + wc * 64 + 8 * fq) >> 1;
        float rsv[2][4], cwv[2][4];
#pragma unroll
        EPI_LOOP_ROWS { const int rl = rl0 + ai * HALF + m * 16; const int pos = u.r0 + rl; const size_t si = (size_t)u.e * ECAP + (pos < ECAP ? pos : 0); rsv[ai][m] = RS[si]; cwv[ai][m] = CW[si]; }
        asm volatile("s_waitcnt vmcnt(0)" ::: "memory");
#pragma unroll
        EPI_LOOP_ROWS { const int rl = rl0 + ai * HALF + m * 16; const float rs = rsv[ai][m], cw = cwv[ai][m];
            bf16_t* rowp = Act + (size_t)(u.pm * BM + rl) * DEXP + colh;
#pragma unroll
            for (int bj = 0; bj < 2; ++bj) { const f32x4 gv = acc[ai][bj][m][0] * rs, uv = acc[ai][bj][m][1] * rs; float o[4];
#pragma unroll
                for (int j = 0; j < 4; ++j) o[j] = gv[j] * sigmoidf_(gv[j]) * uv[j] * cw;
                u32x2 w; w.x = cvt_pk_bf16(o[0], o[1]); w.y = cvt_pk_bf16(o[2], o[3]); *(u32x2*)(rowp + bj * 16) = w; } }
    }
};
struct EpiPle {
    static constexpr bool PERM = false;
    float* XO; const bf16_t* X2b; const bf16_t* T1; const float* RS3;
    __device__ __forceinline__ void operator()(const f32x4 (&acc)[2][2][4][2], const Unit& u, int wr, int wc, int fr, int fq, LAS unsigned char* scr) const {
        const int row0 = u.pm * BM + wr * 64 + fr, col0 = u.pn * BM + wc * 32 + 4 * fq;
#pragma unroll
        EPI_LOOP_ROWS { const int r = row0 + ai * HALF + m * 16; const float rs = RS3[r]; const size_t off = (size_t)r * DM + col0;
#pragma unroll
            for (int bj = 0; bj < 2; ++bj)
#pragma unroll
                for (int n = 0; n < 2; ++n) { const size_t o2 = off + bj * HALF + n * 16; const f32x4 a = acc[ai][bj][m][n] * rs; const u32x2 tw = *(const u32x2*)(T1 + o2); const u32x2 xw = *(const u32x2*)(X2b + o2);
                    f32x4 x;
                    x[0] = bflo(xw.x) + bflo(tw.x) * sigmoidf_(a[0]); x[1] = bfhi(xw.x) + bfhi(tw.x) * sigmoidf_(a[1]); x[2] = bflo(xw.y) + bflo(tw.y) * sigmoidf_(a[2]); x[3] = bfhi(xw.y) + bfhi(tw.y) * sigmoidf_(a[3]);
                    *(f32x4*)(XO + o2) = x; } }
    }
};
struct EpiPleFinal {
    static constexpr bool PERM = true;
    float* OUT; const bf16_t* X2b; const bf16_t* T1; const float* RS3; const float* GN; float* PART; unsigned* PCNT; LAS float* P;
    __device__ __forceinline__ void operator()(f32x4 (&acc)[2][2][4][2], const Unit& u, int wr, int wc, int fr, int fq, LAS unsigned char* scr) const {
        asm volatile("" : "+v"(fr), "+v"(fq));
        const int lane = fq * 16 + fr;
        const int row0 = u.pm * BM + wr * 64 + fr, col0 = u.pn * BM + wc * 64 + 8 * fq;
        const int rowl = u.pm * BM + wr * 64 + (lane >> 3);
        const int colx = u.pn * BM + wc * 64 + 4 * (lane & 7);
        const int coll = u.pn * BM + wc * 64 + 8 * (lane & 7);
        LAS u32x4* f0 = epi_frag(scr, fr, fq); LAS u32x4* f1 = epi_frag(scr, fr, 4 + fq); LAS u32x4* l0 = epi_line(scr, 0, lane); LAS u32x4* l1 = epi_line(scr, 1, lane);
        LAS f32x4* c0 = (LAS f32x4*)epi_frag(scr, fr, 2 * fq); LAS f32x4* c1 = (LAS f32x4*)epi_frag(scr, fr, 2 * fq + 1);
        const int tid = (wr * 4 + wc) * 64 + fq * 16 + fr;
#pragma unroll
        for (int am = 0; am < 4; ++am) {
            const int ai = am >> 1;
            u32x4 tl[2][2], xl[2][2]; float rsv[2];
#pragma unroll
            for (int mm = 0; mm < 2; ++mm) { const int m = 2 * (am & 1) + mm; rsv[mm] = RS3[row0 + ai * HALF + m * 16];
#pragma unroll
                for (int i = 0; i < 2; ++i) { const size_t rr = (size_t)(rowl + ai * HALF + m * 16 + 8 * i); tl[mm][i] = *(const u32x4*)(T1 + rr * (2 * DM) + coll + u.pn * BM); xl[mm][i] = *(const u32x4*)(X2b + rr * DM + coll); } }
            asm volatile("s_waitcnt vmcnt(0)" ::: "memory");
#pragma unroll
            for (int mm = 0; mm < 2; ++mm) { const int m = 2 * (am & 1) + mm; const float rs = rsv[mm]; float ssq = 0.f;
                *l0 = tl[mm][0]; *l1 = tl[mm][1];
                const u32x4 tq[2] = {*f0, *f1};
                *l0 = xl[mm][0]; *l1 = xl[mm][1];
                const u32x4 xq[2] = {*f0, *f1};
#pragma unroll
                for (int bj = 0; bj < 2; ++bj) { const f32x4 a0 = acc[ai][bj][m][0] * rs, a1 = acc[ai][bj][m][1] * rs; const u32x4 t = tq[bj], xx = xq[bj];
                    f32x4 x0, x1;
                    x0[0] = bflo(xx.x) + bflo(t.x) * sigmoidf_(a0[0]); x0[1] = bfhi(xx.x) + bfhi(t.x) * sigmoidf_(a0[1]); x0[2] = bflo(xx.y) + bflo(t.y) * sigmoidf_(a0[2]); x0[3] = bfhi(xx.y) + bfhi(t.y) * sigmoidf_(a0[3]);
                    x1[0] = bflo(xx.z) + bflo(t.z) * sigmoidf_(a1[0]); x1[1] = bfhi(xx.z) + bfhi(t.z) * sigmoidf_(a1[1]); x1[2] = bflo(xx.w) + bflo(t.w) * sigmoidf_(a1[2]); x1[3] = bfhi(xx.w) + bfhi(t.w) * sigmoidf_(a1[3]);
                    acc[ai][bj][m][0] = x0; acc[ai][bj][m][1] = x1;
                    ssq += ((x0[0] * x0[0] + x0[1] * x0[1]) + (x0[2] * x0[2] + x0[3] * x0[3])) + ((x1[0] * x1[0] + x1[1] * x1[1]) + (x1[2] * x1[2] + x1[3] * x1[3])); }
                ssq += __shfl_xor(ssq, 16); ssq += __shfl_xor(ssq, 32);
                if (fq == 0) P[(ai * HALF + wr * 64 + m * 16 + fr) * 4 + wc] = ssq; }
        }
        asm volatile("s_waitcnt lgkmcnt(0)" ::: "memory"); __builtin_amdgcn_s_barrier(); asm volatile("" ::: "memory");
        if (tid < 256) { const f32x4 p4 = *(const LAS f32x4*)(P + tid * 4);
            __hip_atomic_store(PART + (size_t)(u.pm * BM + tid) * 4 + u.pn, (p4[0] + p4[1]) + (p4[2] + p4[3]), __ATOMIC_RELAXED, __HIP_MEMORY_SCOPE_AGENT); }
        asm volatile("s_waitcnt vmcnt(0) lgkmcnt(0)" ::: "memory"); __builtin_amdgcn_s_barrier(); asm volatile("" ::: "memory");
        if (tid < 64) {
            if (tid == 0) __hip_atomic_fetch_add(PCNT + 64 * u.pm, 1u, __ATOMIC_RELAXED, __HIP_MEMORY_SCOPE_AGENT);
            unsigned spins = 0;
            while ((unsigned)__builtin_amdgcn_readfirstlane((int)__hip_atomic_load(PCNT + 64 * u.pm, __ATOMIC_RELAXED, __HIP_MEMORY_SCOPE_AGENT)) < 4u) { __builtin_amdgcn_s_sleep(2); if (++spins > (1u << 20)) break; }
        }
        asm volatile("s_waitcnt vmcnt(0) lgkmcnt(0)" ::: "memory"); __builtin_amdgcn_s_barrier(); asm volatile("" ::: "memory");
        f32x4 gv[2][2];
#pragma unroll
        for (int bj = 0; bj < 2; ++bj)
#pragma unroll
            for (int n = 0; n < 2; ++n) gv[bj][n] = *(const f32x4*)(GN + col0 + bj * 32 + n * 4);
        f32x4 pp[2][4];
#pragma unroll
        EPI_LOOP_ROWS { const float* src = PART + (size_t)(row0 + ai * HALF + m * 16) * 4;
            asm volatile("global_load_dwordx4 %0, %1, off sc1" : "=&v"(pp[ai][m]) : "v"(src) : "memory"); }
        asm volatile("s_waitcnt vmcnt(0)" : "+v"(pp[0][0]), "+v"(pp[0][1]), "+v"(pp[0][2]), "+v"(pp[0][3]), "+v"(pp[1][0]), "+v"(pp[1][1]), "+v"(pp[1][2]), "+v"(pp[1][3]) :: "memory");
#pragma unroll
        EPI_LOOP_ROWS { const f32x4 q = pp[ai][m]; const float rstd = 1.0f / sqrtf(((q[0] + q[1]) + (q[2] + q[3])) * (1.f / DM) + EPS);
            float* op = OUT + (size_t)(rowl + ai * HALF + m * 16) * DM + colx;
#pragma unroll
            for (int bj = 0; bj < 2; ++bj) { *c0 = acc[ai][bj][m][0] * rstd * gv[bj][0]; *c1 = acc[ai][bj][m][1] * rstd * gv[bj][1];
                const f32x4 r0 = *(LAS f32x4*)l0, r1 = *(LAS f32x4*)l1;
                *(f32x4*)(op + bj * 32) = r0; *(f32x4*)(op + bj * 32 + 8 * DM) = r1; } }
    }
};
}

struct Frame {
    LAS unsigned char* lds;
    unsigned* ctl;
    unsigned char* ws;
    int tid, lane, wave, G, vcu, dry;
    const float* in[23];
    float* out;
};
enum { I_X = 0, I_P, I_ATTN_NORM, I_W_IN, I_KV_NORM, I_W_UK, I_W_UV, I_REL_BIAS, I_W_BA, I_W_BB, I_W_OUT, I_FFN_NORM, I_W_R1, I_B_R1, I_W_R2, I_B_R2,
       I_W_GATE, I_W_UP, I_W_DOWN, I_PLE_NORM, I_W_PLE_GATE, I_W_PLE, I_FINAL_NORM };
constexpr int IN_COLS = 4808;

template <class Map>
__device__ __forceinline__ void tr_item(const Map& mp, bf16_t* WT, int K, int n0, int k0, LAS float* scr_, int lane) {
    LAS unsigned* scr = (LAS unsigned*)scr_;
    const int n4 = lane & 31, hb = lane >> 5;
#pragma unroll 1
    for (int hf = 0; hf < 2; ++hf) {
        f32x4 tv[16];
#pragma unroll
        for (int j = 0; j < 16; ++j) tv[j] = mp.get4(k0 + 32 * hf + 4 * (j >> 1) + 2 * hb + (j & 1), n0 + 4 * n4);
#pragma unroll
        for (int m = 0; m < 8; ++m)
#pragma unroll
            for (int c = 0; c < 4; ++c) { const int n = 4 * n4 + c; scr[n * 32 + ((16 * hf + 2 * m + hb) ^ ((n4 ^ c) & 31))] = pk2(tv[2 * m][c], tv[2 * m + 1][c]); }
    }
    LDS_WAIT(); asm volatile("" ::: "memory");
    const int r = lane >> 3, c8 = lane & 7;
#pragma unroll
    for (int s = 0; s < 16; ++s) { const int n = 8 * s + r, f = ((n >> 2) & 31) ^ (n & 3); const LAS unsigned* p = scr + n * 32;
        u32x4 o; o.x = p[(4 * c8 + 0) ^ f]; o.y = p[(4 * c8 + 1) ^ f]; o.z = p[(4 * c8 + 2) ^ f]; o.w = p[(4 * c8 + 3) ^ f];
        *(u32x4*)(WT + (size_t)(n0 + n) * K + k0 + 8 * c8) = o; }
    LDS_WAIT(); asm volatile("" ::: "memory");
}
struct MapWin {
    const float* W;
    __device__ __forceinline__ f32x4 get4(int k, int n) const {
        int src; float sc = 1.f;
        if (n < 1152) src = 512 + (n - 1024);
        else if (n < 1216) src = 1152 + (n - 1152);
        else if (n < 1224) src = 1216 + (n - 1216);
        else if (n < 1280) src = -1;
        else if (n < 1792) src = 640 + (n - 1280);
        else if (n < 3328) { src = 1224 + (n - 1792); if (n < 2304) sc = 0.125f; }
        else if (n < 4352) src = 2760 + (n - 3328);
        else src = 3784 + (n - 4352);
        if (src < 0) return (f32x4){0.f, 0.f, 0.f, 0.f};
        return __builtin_nontemporal_load((const f32x4*)(W + (size_t)k * IN_COLS + src)) * sc;
    }
};
struct MapPlain { const float* W; int ldw; const float* gain;
    __device__ __forceinline__ f32x4 get4(int k, int n) const { const f32x4 v = __builtin_nontemporal_load((const f32x4*)(W + (size_t)k * ldw + n)); return gain ? v * gain[k] : v; } };
struct MapGU { const float* Wg; const float* Wu; const float* gain;
    __device__ __forceinline__ f32x4 get4(int k, int n) const { const int q = n >> 3; const long long dl = (n & 4) ? (long long)(Wu - Wg) : 0ll; return __builtin_nontemporal_load((const f32x4*)(Wg + dl + (long long)k * DEXP + 4 * q)) * gain[k]; } };

__device__ __forceinline__ void p0_prologue(Frame& F) {
    LAS float* scr = (LAS float*)(F.lds + F.wave * 16384);
    const int gw = F.vcu * NWAVES + F.wave, NGW = F.G * NWAVES, lane = F.lane;
    unsigned char* ws = F.ws;
    bf16_t* WinT = (bf16_t*)(ws + W_IN); bf16_t* WcombT = (bf16_t*)(ws + W_COMB); bf16_t* WbbT = (bf16_t*)(ws + W_BB); bf16_t* WoutT = (bf16_t*)(ws + W_OUT);
    constexpr int N_WIN = 34 * 16, N_BB = 8 * 8, N_OUT = 8 * 16, N_PLE = 8 * 4;
    constexpr int NITEMS = N_WIN + N_BB + N_OUT + N_PLE;
    for (int step = 0; step < 2; ++step) {
    if ((step == 0) != ((F.wave & 1) != 0)) {
    for (int it = gw; it < NITEMS; it += NGW) {
        int r = it;
        if (r < N_WIN) { MapWin mp{F.in[I_W_IN]}; tr_item(mp, WinT, DM, 1024 + 128 * (r % 34), 64 * (r / 34), scr, lane); continue; } r -= N_WIN;
        if (r < N_BB) { MapPlain mp{F.in[I_W_BB], DM, nullptr}; tr_item(mp, WbbT, 512, 128 * (r % 8), 64 * (r / 8), scr, lane); continue; } r -= N_BB;
        if (r < N_OUT) { MapPlain mp{F.in[I_W_OUT], DM, nullptr}; tr_item(mp, WoutT, DM, 128 * (r % 8), 64 * (r / 8), scr, lane); continue; } r -= N_OUT;
        { MapPlain mp{F.in[I_W_PLE], DM, nullptr}; tr_item(mp, (bf16_t*)(ws + W_PLE), 256, 128 * (r % 8), 64 * (r / 8), scr, lane); }
    }
    for (int it = gw; it < 2048; it += NGW) {
        const int h = it >> 8, cb = (it >> 4) & 15, kb = it & 15, k = kb * 64 + lane;
        const float* wr_ = F.in[I_W_IN] + (size_t)k * IN_COLS + h * 64;
        f32x2 wv[32];
#pragma unroll
        for (int d = 0; d < 64; d += 4) { const f32x4 v = *(const f32x4*)(wr_ + d); wv[d / 2] = (f32x2){v[0], v[1]}; wv[d / 2 + 1] = (f32x2){v[2], v[3]}; }
        float o[8];
#pragma unroll
        for (int cc = 0; cc < 8; ++cc) { asm volatile("" ::: "memory"); const f32x2* uk = (const f32x2*)(F.in[I_W_UK] + (size_t)(h * 128 + cb * 8 + cc) * 64); f32x2 a = (f32x2){0.f, 0.f};
#pragma unroll
            for (int d = 0; d < 32; ++d) a += wv[d] * uk[d];
            o[cc] = (a[0] + a[1]) * 0.125f; }
#pragma unroll
        for (int cc = 0; cc < 8; ++cc) WinT[(size_t)(h * 128 + cb * 8 + cc) * DM + k] = (bf16_t)f2bf(o[cc]);
    }
    for (int it = gw; it < 2048; it += NGW) {
        const int h = it >> 8, cb = (it >> 4) & 15, nb = it & 15, n = nb * 64 + lane;
        f32x2 bv[32];
#pragma unroll
        for (int d = 0; d < 32; ++d) { bv[d][0] = F.in[I_W_BA][(size_t)(h * 64 + 2 * d) * DM + n]; bv[d][1] = F.in[I_W_BA][(size_t)(h * 64 + 2 * d + 1) * DM + n]; }
        float o[8];
#pragma unroll
        for (int cc = 0; cc < 8; ++cc) { asm volatile("" ::: "memory"); const f32x2* uv = (const f32x2*)(F.in[I_W_UV] + (size_t)(h * 128 + cb * 8 + cc) * 64); f32x2 a = (f32x2){0.f, 0.f};
#pragma unroll
            for (int d = 0; d < 32; ++d) a += bv[d] * uv[d];
            o[cc] = a[0] + a[1]; }
        u32x4 w; w.x = pk2(o[0], o[1]); w.y = pk2(o[2], o[3]); w.z = pk2(o[4], o[5]); w.w = pk2(o[6], o[7]);
        *(u32x4*)(WcombT + (size_t)n * DM + h * 128 + cb * 8) = w;
    }
    } else {
    {
        bf16_t* Hb = (bf16_t*)(ws + WS_H); bf16_t* Pb = (bf16_t*)(ws + WS_PB);
        f32x4 gn[4];
#pragma unroll
        for (int j = 0; j < 4; ++j) gn[j] = *(const f32x4*)(F.in[I_ATTN_NORM] + 4 * lane + 256 * j);
        const int rpw = (NTOK + NGW - 1) / NGW, mend = (gw + 1) * rpw < NTOK ? (gw + 1) * rpw : NTOK;
        for (int m0 = gw * rpw; m0 < mend; m0 += 4) {
            f32x4 v[4][4], pv[4];
#pragma unroll
            for (int u = 0; u < 4; ++u) { const int m = (m0 + u < mend) ? m0 + u : m0; const f32x4* xr = (const f32x4*)(F.in[I_X] + (size_t)m * DM) + lane;
#pragma unroll
                for (int j = 0; j < 4; ++j) v[u][j] = __builtin_nontemporal_load(xr + 64 * j);
                pv[u] = __builtin_nontemporal_load((const f32x4*)(F.in[I_P] + (size_t)m * 256) + lane); }
#pragma unroll
            for (int u = 0; u < 4; ++u) { const int m = m0 + u; if (m < mend) {
                float s = 0.f;
#pragma unroll
                for (int j = 0; j < 4; ++j) s += (v[u][j][0] * v[u][j][0] + v[u][j][1] * v[u][j][1]) + (v[u][j][2] * v[u][j][2] + v[u][j][3] * v[u][j][3]);
                const float rstd = 1.0f / sqrtf(wave_sum(s) * (1.f / DM) + EPS);
                u32x2* o8 = (u32x2*)(Hb + (size_t)m * DM) + lane;
#pragma unroll
                for (int j = 0; j < 4; ++j) { const f32x4 y = v[u][j] * rstd * gn[j]; u32x2 w; w.x = pk2(y[0], y[1]); w.y = pk2(y[2], y[3]); o8[64 * j] = w; }
                u32x2 pw; pw.x = pk2(pv[u][0], pv[u][1]); pw.y = pk2(pv[u][2], pv[u][3]); *((u32x2*)(Pb + (size_t)m * 256) + lane) = pw; } }
        }
    }
    }
    }
}

__device__ __forceinline__ void p0b_late_weights(Frame& F) {
    LAS float* scr = (LAS float*)(F.lds + F.wave * 16384);
    const int gw = F.vcu * NWAVES + F.wave, NGW = F.G * NWAVES, lane = F.lane;
    unsigned char* ws = F.ws;
    bf16_t* WguT = (bf16_t*)(ws + W_GU); bf16_t* WdnT = (bf16_t*)(ws + W_DN); bf16_t* WpgT = (bf16_t*)(ws + W_PG);
    constexpr int N_GU = 32 * 4 * 16, N_DN = 32 * 8 * 4, N_PG = 8 * 16;
    constexpr int NITEMS = N_GU + N_DN + N_PG;
    asm volatile("s_waitcnt vmcnt(0) lgkmcnt(0)" ::: "memory");
    for (int it = gw; it < NITEMS; it += NGW) {
        int r = it;
        if (r < N_GU) { const int e = r / 64, q = r % 64; MapGU mp{F.in[I_W_GATE] + (size_t)e * DM * DEXP, F.in[I_W_UP] + (size_t)e * DM * DEXP, F.in[I_FFN_NORM]};
            tr_item(mp, WguT + (size_t)e * 512 * DM, DM, 128 * (q % 4), 64 * (q / 4), scr, lane); continue; } r -= N_GU;
        if (r < N_DN) { const int e = r / 32, q = r % 32; MapPlain mp{F.in[I_W_DOWN] + (size_t)e * DEXP * DM, DM, nullptr};
            tr_item(mp, WdnT + (size_t)e * DM * DEXP, DEXP, 128 * (q % 8), 64 * (q / 8), scr, lane); continue; } r -= N_DN;
        { MapPlain mp{F.in[I_W_PLE_GATE], DM, F.in[I_PLE_NORM]}; tr_item(mp, WpgT, DM, 128 * (r % 8), 64 * (r / 8), scr, lane); }
    }
    {
        bf16_t* RH = (bf16_t*)(ws + W_RHI); bf16_t* RL = (bf16_t*)(ws + W_RLO);
        for (int idx = gw * 64 + lane; idx < 48 * DM; idx += NGW * 64) {
            const int n = idx >> 10, k = idx & 1023; float v = 0.f;
            if (n < 4) v = F.in[I_W_R1][k * 4 + n]; else if (n < 36) { const int g = (n - 4) >> 3, e = (n - 4) & 7; v = F.in[I_W_R2][((size_t)g * DM + k) * 8 + e]; }
            v *= F.in[I_FFN_NORM][k];
            const unsigned hi = f2bf(v); const float lo = v - __builtin_bit_cast(float, hi << 16);
            RH[idx] = (bf16_t)hi; RL[idx] = (bf16_t)f2bf(lo);
        }
    }
}

__device__ __forceinline__ void p1b_extract(Frame& F) {
    const int gw = F.vcu * NWAVES + F.wave, NGW = F.G * NWAVES, lane = F.lane;
    const bf16_t* A = (const bf16_t*)(F.ws + WS_A); unsigned* ckvn = (unsigned*)(F.ws + S_CKVN);
    const float g0 = F.in[I_KV_NORM][2 * lane], g1 = F.in[I_KV_NORM][2 * lane + 1];
    for (int m0 = gw; m0 < NTOK; m0 += 8 * NGW) {
        unsigned wv[8];
#pragma unroll
        for (int u = 0; u < 8; ++u) { const int m = (m0 + u * NGW < NTOK) ? m0 + u * NGW : m0; const unsigned* row = (const unsigned*)(A + (size_t)m * LDA);
            wv[u] = row[CA_CKV / 2 + lane]; }
#pragma unroll
        for (int u = 0; u < 8; ++u) { const int m = m0 + u * NGW; if (m < NTOK) {
            const float a = bflo(wv[u]), b = bfhi(wv[u]);
            const float rstd = 1.0f / sqrtf(wave_sum(a * a + b * b) * (1.f / 128.f) + EPS);
            ckvn[(size_t)m * 64 + lane] = pk2(a * rstd * g0, b * rstd * g1);
            } }
    }
}

__device__ __forceinline__ float wave_max(float v) {
#pragma unroll
    for (int o = 1; o < 64; o <<= 1) v = fmaxf(v, __shfl_xor(v, o));
    return v;
}
__device__ __forceinline__ float wave_min(float v) {
#pragma unroll
    for (int o = 1; o < 64; o <<= 1) v = fminf(v, __shfl_xor(v, o));
    return v;
}
__device__ __forceinline__ unsigned wave_scan_incl(unsigned v) {
    v += (unsigned)__builtin_amdgcn_update_dpp(0, (int)v, 0x111, 0xf, 0xf, false);
    v += (unsigned)__builtin_amdgcn_update_dpp(0, (int)v, 0x112, 0xf, 0xf, false);
    v += (unsigned)__builtin_amdgcn_update_dpp(0, (int)v, 0x114, 0xf, 0xf, false);
    v += (unsigned)__builtin_amdgcn_update_dpp(0, (int)v, 0x118, 0xf, 0xf, false);
    v += (unsigned)__builtin_amdgcn_update_dpp(0, (int)v, 0x142, 0xa, 0xf, false);
    v += (unsigned)__builtin_amdgcn_update_dpp(0, (int)v, 0x143, 0xc, 0xf, false);
    return v;
}
template <int CTRL> __device__ __forceinline__ float dpp_f(float x) { return __builtin_bit_cast(float, __builtin_amdgcn_update_dpp(__builtin_bit_cast(int, x), __builtin_bit_cast(int, x), CTRL, 0xf, 0xf, false)); }
__device__ __forceinline__ float rdl(float x, int l) { return __builtin_bit_cast(float, __builtin_amdgcn_readlane(__builtin_bit_cast(int, x), l)); }
__device__ __forceinline__ float wave_max_u(float x) {
    x = fmaxf(x, dpp_f<0xB1>(x)); x = fmaxf(x, dpp_f<0x4E>(x)); x = fmaxf(x, dpp_f<0x141>(x)); x = fmaxf(x, dpp_f<0x140>(x));
    return fmaxf(fmaxf(rdl(x, 0), rdl(x, 16)), fmaxf(rdl(x, 32), rdl(x, 48)));
}
__device__ __forceinline__ float wave_min_u(float x) {
    x = fminf(x, dpp_f<0xB1>(x)); x = fminf(x, dpp_f<0x4E>(x)); x = fminf(x, dpp_f<0x141>(x)); x = fminf(x, dpp_f<0x140>(x));
    return fminf(fminf(rdl(x, 0), rdl(x, 16)), fminf(rdl(x, 32), rdl(x, 48)));
}
__device__ __noinline__ void topk_tie_lds(const LAS float* sc, int t, unsigned short* out, int lane, float lo, float hi, int chi, LAS unsigned* scr) {
    const int nr = (t + 64) >> 6;
    const float NINF = -__builtin_inff();
#define SCV(rr) ((64 * (rr) + lane <= t) ? sc[64 * (rr) + lane] : NINF)
    LAS float* cv = (LAS float*)scr; LAS int* ci = (LAS int*)(scr + 64);
    int m = 0;
    for (int rr = 0; rr < nr; ++rr) { const float x = SCV(rr); const bool e = x >= lo && x < hi;
        const unsigned long long me = __ballot(e);
        const int pos = m + (int)__builtin_amdgcn_mbcnt_hi((unsigned)(me >> 32), __builtin_amdgcn_mbcnt_lo((unsigned)me, 0u));
        if (e && pos < 64) { cv[pos] = x; ci[pos] = 64 * rr + lane; }
        m += __builtin_popcountll(me); }
    asm volatile("s_waitcnt lgkmcnt(0)" ::: "memory");
    float Tv; int Ti;
    if (m <= 64) {
        const int need = 256 - chi;
        const float myv = lane < m ? cv[lane] : NINF; const int myi = lane < m ? ci[lane] : 0x7fffffff;
        int rank = 0;
        for (int j = 0; j < m; ++j) { const float vj = rdl(myv, j); const int ij = __builtin_amdgcn_readlane(myi, j); rank += (vj > myv || (vj == myv && ij < myi)) ? 1 : 0; }
        const unsigned long long mt = __ballot(lane < m && rank == need - 1);
        const int tl = (int)__builtin_ctzll(mt | (1ull << 63));
        Tv = rdl(myv, tl); Ti = __builtin_amdgcn_readlane(myi, tl);
    } else {
        for (int it = 0; it < 200; ++it) {
            const float mid = 0.5f * lo + 0.5f * hi;
            if (!(mid > lo && mid < hi)) break;
            int c = 0;
            for (int rr = 0; rr < nr; ++rr) c += __builtin_popcountll(__ballot(SCV(rr) >= mid));
            if (c >= 256) lo = mid; else { hi = mid; chi = c; }
        }
        int need = 256 - chi, eqb = 0; Tv = lo; Ti = -1;
        for (int rr = 0; rr < nr; ++rr) { const bool eq = SCV(rr) == lo; const unsigned long long meq = __ballot(eq);
            const int rk = eqb + (int)__builtin_amdgcn_mbcnt_hi((unsigned)(meq >> 32), __builtin_amdgcn_mbcnt_lo((unsigned)meq, 0u));
            const unsigned long long hit = __ballot(eq && rk == need - 1);
            if (hit) Ti = 64 * rr + (int)__builtin_ctzll(hit);
            eqb += __builtin_popcountll(meq); }
        hi = __builtin_inff(); lo = Tv;
    }
    int base = 0;
    for (int rr = 0; rr < nr; ++rr) { const float x = SCV(rr); const int idx = 64 * rr + lane;
        const bool sl = (x >= hi) || (x >= lo && x < hi && (x > Tv || (x == Tv && idx <= Ti)));
        const unsigned long long ms = __ballot(sl);
        const int pos = base + (int)__builtin_amdgcn_mbcnt_hi((unsigned)(ms >> 32), __builtin_amdgcn_mbcnt_lo((unsigned)ms, 0u));
        if (sl && pos < 256) out[pos] = (unsigned short)idx;
        base += __builtin_popcountll(ms); }
#undef SCV
}
template <int PAR>
__device__ __forceinline__ void topk_fallback(const float (&v)[64], int t, unsigned short* out, int lane, LAS float* sc, float lo, float hi, int chi) {
    asm volatile("s_waitcnt lgkmcnt(0)" ::: "memory");
#pragma unroll
    for (int rr = 0; rr < 32; ++rr) sc[64 * rr + lane] = v[2 * rr + PAR];
    asm volatile("s_waitcnt lgkmcnt(0)" ::: "memory");
    topk_tie_lds(sc, t, out, lane, lo, hi, chi, (LAS unsigned*)(sc + 2048));
}
template <int PAR>
__device__ __forceinline__ bool topk_fast(const float (&v)[64], int t, unsigned short* out, int lane, LAS unsigned short* cb, float& blo, float& bhi, int& bchi) {
    const int n = t + 1;
    if (n <= 256) {
#pragma unroll
        for (int j = 0; j < 4; ++j) { const int idx = 64 * j + lane; out[idx] = (unsigned short)(idx < n ? idx : 0); }
        return true;
    }
    const int ng = (n + 255) >> 8;
    const float NINF = -__builtin_inff(), PINF = __builtin_inff();
    float mx0 = NINF, mx1 = NINF, mn0 = PINF, mn1 = PINF;
#pragma unroll
    for (int g = 0; g < 8; ++g) if (g < ng) {
#pragma unroll
        for (int j = 0; j < 4; j += 2) { const float x = v[2 * (4 * g + j) + PAR], y = v[2 * (4 * g + j + 1) + PAR];
            mx0 = fmaxf(mx0, x); mx1 = fmaxf(mx1, y); mn0 = fminf(mn0, x == NINF ? PINF : x); mn1 = fminf(mn1, y == NINF ? PINF : y); } }
    float hi = __builtin_inff(), lo = wave_min_u(fminf(mn0, mn1)); const float vmax = wave_max_u(fmaxf(mx0, mx1));
    int chi = 0;
    const int slots = 256 * ng;
    unsigned cl0 = 0, cl1 = 0, cl2 = 0, cl3 = 0;
    bool found = false;
    for (int it = 0; it < 24; ++it) {
        const float mid = (it == 0) ? vmax : 0.5f * lo + 0.5f * hi;
        if (!(mid > lo && mid < hi)) break;
        cl0 = cl1 = cl2 = cl3 = 0;
#pragma unroll
        for (int g = 0; g < 8; ++g) if (g < ng) {
            cl0 += __builtin_bit_cast(unsigned, v[2 * (4 * g + 0) + PAR] - mid) >> 31; cl1 += __builtin_bit_cast(unsigned, v[2 * (4 * g + 1) + PAR] - mid) >> 31;
            cl2 += __builtin_bit_cast(unsigned, v[2 * (4 * g + 2) + PAR] - mid) >> 31; cl3 += __builtin_bit_cast(unsigned, v[2 * (4 * g + 3) + PAR] - mid) >> 31; }
        const unsigned below = (unsigned)__builtin_amdgcn_readlane((int)wave_scan_incl((cl0 + cl1) + (cl2 + cl3)), 63);
        const int c = slots - (int)below;
        if (c == 256) { found = true; lo = mid; break; }
        if (c > 256) lo = mid; else { hi = mid; chi = c; }
    }
    if (!found) { blo = lo; bhi = hi; bchi = chi; return false; }
    const float T = lo;
    const unsigned mine = (unsigned)(4 * ng) - ((cl0 + cl1) + (cl2 + cl3));
    unsigned pos = wave_scan_incl(mine) - mine;
#pragma unroll
    for (int g = 0; g < 8; ++g) if (g < ng) {
#pragma unroll
        for (int j = 0; j < 4; ++j) { const int rr = 4 * g + j; const unsigned sel = 1u - (__builtin_bit_cast(unsigned, v[2 * rr + PAR] - T) >> 31);
            int ln = lane; asm volatile("" : "+v"(ln));
            LAS unsigned short* dst = sel ? cb + pos : cb + 256 + ln;
            *dst = (unsigned short)(64 * rr + ln); pos += sel; } }
    asm volatile("s_waitcnt lgkmcnt(0)" ::: "memory");
    *(u32x2*)(out + 4 * lane) = *(const LAS u32x2*)(cb + 4 * lane);
    return true;
}

#ifndef P2_DEPTH
#define P2_DEPTH 3
#endif
__device__ __forceinline__ void p2_unit(Frame& F, int b, int qb) {
    const int lane = F.lane, w = F.wave, r = lane & 31, hh = lane >> 5;
    const bf16_t* A = (const bf16_t*)(F.ws + WS_A);
    const bf16_t* KI = A + (size_t)b * SEQ * LDA + CA_KIDX;
    unsigned short* SEL = (unsigned short*)(F.ws + S_SEL);
    const int tq0 = qb * 32 + 4 * w;
    bf16x8 af[4];
    { const bf16_t* qrow = A + (size_t)(b * SEQ + tq0 + (r >> 3)) * LDA + CA_QIDX + (r & 7) * 64 + 8 * hh;
#pragma unroll
      for (int s = 0; s < 4; ++s) af[s] = *(const bf16x8*)(qrow + 16 * s); }
    float wq[16];
#pragma unroll
    for (int i = 0; i < 16; ++i) wq[i] = bf2f(A[(size_t)(b * SEQ + tq0 + (i >> 2)) * LDA + CA_WIDX + (i & 3) + 4 * hh]);
    const float NINF = -__builtin_inff();
    float S01[64], S23[64];
#pragma unroll
    for (int i = 0; i < 64; ++i) { S01[i] = NINF; S23[i] = NINF; }
    const int nkt = qb + 1;
    const bool dm01 = r > 4 * w + hh, dm23 = r > 4 * w + 2 + hh;
    const bf16_t* krow = (const bf16_t*)(F.ws + S_KIDX) + (size_t)b * SEQ * 64 + 8 * lane;
    bf16x8 bfr[P2_DEPTH][4];
#pragma unroll
    for (int d = 0; d < P2_DEPTH; ++d) if (d < nkt) {
#pragma unroll
        for (int s = 0; s < 4; ++s) bfr[d][s] = gld<bf16x8>(krow + 2048 * d + 512 * s); }
#pragma unroll
    for (int kt = 0; kt < 64; ++kt) if (kt < nkt) {
        asm volatile("" : "+v"(krow));
        f32x16 acc;
#pragma unroll
        for (int i = 0; i < 16; ++i) acc[i] = 0.f;
#pragma unroll
        for (int s = 0; s < 4; ++s) acc = __builtin_amdgcn_mfma_f32_32x32x16_bf16(af[s], bfr[kt % P2_DEPTH][s], acc, 0, 0, 0);
        if (kt + P2_DEPTH < nkt) {
#pragma unroll
            for (int s = 0; s < 4; ++s) bfr[kt % P2_DEPTH][s] = gld<bf16x8>(krow + 2048 * P2_DEPTH + 512 * s); }
        float p[4];
#pragma unroll
        for (int q = 0; q < 4; ++q) p[q] = (wq[4 * q] * fmaxf(acc[4 * q], 0.f) + wq[4 * q + 1] * fmaxf(acc[4 * q + 1], 0.f)) + (wq[4 * q + 2] * fmaxf(acc[4 * q + 2], 0.f) + wq[4 * q + 3] * fmaxf(acc[4 * q + 3], 0.f));
        auto r01 = __builtin_amdgcn_permlane32_swap(__builtin_bit_cast(unsigned, p[0]), __builtin_bit_cast(unsigned, p[1]), false, false);
        auto r23 = __builtin_amdgcn_permlane32_swap(__builtin_bit_cast(unsigned, p[2]), __builtin_bit_cast(unsigned, p[3]), false, false);
        float s01 = __builtin_bit_cast(float, (unsigned)r01[0]) + __builtin_bit_cast(float, (unsigned)r01[1]);
        float s23 = __builtin_bit_cast(float, (unsigned)r23[0]) + __builtin_bit_cast(float, (unsigned)r23[1]);
        if (kt == qb) { if (dm01) s01 = NINF; if (dm23) s23 = NINF; }
        S01[kt] = s01; S23[kt] = s23;
        krow += 2048;
    }
#pragma unroll
    for (int rr = 0; rr < 32; ++rr) {
        auto a = __builtin_amdgcn_permlane32_swap(__builtin_bit_cast(unsigned, S01[2 * rr]), __builtin_bit_cast(unsigned, S01[2 * rr + 1]), false, false);
        S01[2 * rr] = __builtin_bit_cast(float, (unsigned)a[0]); S01[2 * rr + 1] = __builtin_bit_cast(float, (unsigned)a[1]);
        auto c2 = __builtin_amdgcn_permlane32_swap(__builtin_bit_cast(unsigned, S23[2 * rr]), __builtin_bit_cast(unsigned, S23[2 * rr + 1]), false, false);
        S23[2 * rr] = __builtin_bit_cast(float, (unsigned)c2[0]); S23[2 * rr + 1] = __builtin_bit_cast(float, (unsigned)c2[1]);
    }
    unsigned short* o = SEL + (size_t)(b * SEQ + tq0) * 256;
    LAS float* scf = (LAS float*)(F.lds + w * 16384); float blo = 0.f, bhi = 0.f; int bchi = 0;
    LAS unsigned short* dmy = (LAS unsigned short*)(F.lds + w * 16384 + 12288);
    if (!topk_fast<0>(S01, tq0 + 0, o, lane, dmy, blo, bhi, bchi)) topk_fallback<0>(S01, tq0 + 0, o, lane, scf, blo, bhi, bchi);
    if (!topk_fast<1>(S01, tq0 + 1, o + 256, lane, dmy, blo, bhi, bchi)) topk_fallback<1>(S01, tq0 + 1, o + 256, lane, scf, blo, bhi, bchi);
    if (!topk_fast<0>(S23, tq0 + 2, o + 512, lane, dmy, blo, bhi, bchi)) topk_fallback<0>(S23, tq0 + 2, o + 512, lane, scf, blo, bhi, bchi);
    if (!topk_fast<1>(S23, tq0 + 3, o + 768, lane, dmy, blo, bhi, bchi)) topk_fallback<1>(S23, tq0 + 3, o + 768, lane, scf, blo, bhi, bchi);
}
__device__ __forceinline__ void p2_indexer(Frame& F) {
    for (int u = F.vcu; u < 1024; u += F.G) {
        const int c = u & 255, i = u >> 8, b = c >> 4, j = c & 15;
        const int qb = (i == 0) ? j : (i == 1) ? 63 - j : (i == 2) ? 16 + j : 47 - j;
        p2_unit(F, b, qb);
    }
}

__device__ __forceinline__ unsigned offb(unsigned row, unsigned ch) { return 256u * row + 16u * (ch ^ (((row & 3u) << 2) | ((row >> 2) & 3u))); }
__device__ __forceinline__ s16x4 ds_tr(LAS unsigned char* p) { return __builtin_bit_cast(s16x4, __builtin_amdgcn_ds_read_tr16_b64_v4i16((LAS v4i16_t*)p)); }
constexpr int P3_IDXROW = MISC_OFF + 1024, P3_LUT = MISC_OFF + 4096;
__device__ __forceinline__ int t5_bucket(int d) {
    if (d < 16) return d;
    const int lg = 16 + (int)(__logf((float)d / 16.0f) / 2.0794415416798357f * 16.0f);
    return lg < 31 ? lg : 31;
}
__device__ __forceinline__ float xmax4(float x) {
    auto a = __builtin_amdgcn_permlane32_swap(__builtin_bit_cast(unsigned, x), __builtin_bit_cast(unsigned, x), false, false);
    x = fmaxf(__builtin_bit_cast(float, (unsigned)a[0]), __builtin_bit_cast(float, (unsigned)a[1]));
    auto b = __builtin_amdgcn_permlane16_swap(__builtin_bit_cast(unsigned, x), __builtin_bit_cast(unsigned, x), false, false);
    return fmaxf(__builtin_bit_cast(float, (unsigned)b[0]), __builtin_bit_cast(float, (unsigned)b[1]));
}
__device__ __forceinline__ float xsum4(float x) {
    auto a = __builtin_amdgcn_permlane32_swap(__builtin_bit_cast(unsigned, x), __builtin_bit_cast(unsigned, x), false, false);
    x = __builtin_bit_cast(float, (unsigned)a[0]) + __builtin_bit_cast(float, (unsigned)a[1]);
    auto b = __builtin_amdgcn_permlane16_swap(__builtin_bit_cast(unsigned, x), __builtin_bit_cast(unsigned, x), false, false);
    return __builtin_bit_cast(float, (unsigned)b[0]) + __builtin_bit_cast(float, (unsigned)b[1]);
}
__device__ __forceinline__ void p3_query(Frame& F, int b, int t, const bf16x8 bfrag) {
    const int lane = F.lane, w = F.wave, l15 = lane & 15, g4 = lane >> 4;
    bf16_t* A = (bf16_t*)(F.ws + WS_A);
    const unsigned char* ckv = F.ws + S_CKVN + (size_t)b * SEQ * 256;
    const unsigned short* selq = (const unsigned short*)(F.ws + S_SEL) + (size_t)(b * SEQ + t) * 256;
    LAS unsigned char* buf = F.lds + w * 16384;
    LAS unsigned short* idxrow = (LAS unsigned short*)(F.lds + P3_IDXROW + w * 128);
    const LAS unsigned char* lut = F.lds + P3_LUT;
    bf16_t* qrow = A + (size_t)(b * SEQ + t) * LDA + CA_QABS;
    bf16x8 qf[4];
#pragma unroll
    for (int s = 0; s < 4; ++s) { if (l15 < 8) qf[s] = *(const bf16x8*)(qrow + l15 * 128 + 32 * s + 8 * g4); else qf[s] = (bf16x8){0, 0, 0, 0, 0, 0, 0, 0}; }
    const float NINF = -__builtin_inff();
    float m = NINF, lsum = 0.f;
    f32x4 O[8];
#pragma unroll
    for (int c = 0; c < 8; ++c) O[c] = (f32x4){0.f, 0.f, 0.f, 0.f};
    const int nvalid = (t + 1 < 256) ? t + 1 : 256, nchunk = (nvalid + 63) >> 6;
    const unsigned RT = 8 * ((unsigned)l15 >> 2) + ((unsigned)l15 & 3);
    u32x4 ia[4][2]; unsigned short mya[4];
#pragma unroll
    for (int ch = 0; ch < 4; ++ch) if (ch < nchunk) { ia[ch][0] = *(const u32x4*)(selq + 64 * ch + 16 * g4); ia[ch][1] = *(const u32x4*)(selq + 64 * ch + 16 * g4 + 8); mya[ch] = selq[64 * ch + 16 * g4 + l15]; }
#pragma unroll
    for (int ch = 0; ch < 4; ++ch) if (ch < nchunk) {
        idxrow[4 * l15 + g4] = mya[ch];
        const unsigned ir[8] = {ia[ch][0].x, ia[ch][0].y, ia[ch][0].z, ia[ch][0].w, ia[ch][1].x, ia[ch][1].y, ia[ch][1].z, ia[ch][1].w};
#pragma unroll
        for (int g = 0; g < 16; ++g) {
            const unsigned idx = (g & 1) ? (ir[g >> 1] >> 16) : (ir[g >> 1] & 0xffffu);
            const unsigned cpos = (unsigned)l15 ^ (((unsigned)g4 << 2) | (unsigned)(g & 3));
            __builtin_amdgcn_global_load_lds((const unsigned*)(ckv + (size_t)((idx << 8) + (cpos << 4))), (LAS unsigned*)(buf + g * 1024), 16, 0, 0);
        }
        asm volatile("s_waitcnt vmcnt(0) lgkmcnt(0)" ::: "memory");
        f32x4 st[2][2];
        bf16x8 oh[2][2];
#pragma unroll
        for (int ks = 0; ks < 2; ++ks)
#pragma unroll
            for (int u = 0; u < 2; ++u) { int d = t - (int)idxrow[32 * ks + 4 * u + RT]; d = d > 128 ? 128 : d; oh[ks][u] = *(const LAS bf16x8*)(lut + d * 64 + g4 * 16); }
#pragma unroll
        for (int ks = 0; ks < 2; ++ks)
#pragma unroll
            for (int u = 0; u < 2; ++u) { f32x4 acc = (f32x4){0.f, 0.f, 0.f, 0.f}; const unsigned R = 32 * ks + 4 * u + RT;
#pragma unroll
                for (int s = 0; s < 4; ++s) { const bf16x8 a = *(const LAS bf16x8*)(buf + offb(R, 4 * s + g4)); acc = __builtin_amdgcn_mfma_f32_16x16x32_bf16(a, qf[s], acc, 0, 0, 0); }
                st[ks][u] = __builtin_amdgcn_mfma_f32_16x16x32_bf16(oh[ks][u], bfrag, acc, 0, 0, 0); }
        if (64 * (ch + 1) > nvalid) {
#pragma unroll
            for (int ks = 0; ks < 2; ++ks)
#pragma unroll
                for (int u = 0; u < 2; ++u)
#pragma unroll
                    for (int rg = 0; rg < 4; ++rg) { const int slot = 64 * ch + 16 * rg + 8 * ks + 2 * g4 + u; if (slot >= nvalid) st[ks][u][rg] = NINF; } }
        float cm = NINF;
#pragma unroll
        for (int ks = 0; ks < 2; ++ks)
#pragma unroll
            for (int u = 0; u < 2; ++u) cm = fmaxf(fmaxf(cm, fmaxf(st[ks][u][0], st[ks][u][1])), fmaxf(st[ks][u][2], st[ks][u][3]));
        cm = xmax4(cm);
        if (__any(cm > m + 8.0f)) {
            const float mnew = fmaxf(m, cm), alpha = fast_exp(m - mnew);
            m = mnew; lsum *= alpha;
            float aO[4];
#pragma unroll
            for (int rg = 0; rg < 4; ++rg) aO[rg] = __shfl(alpha, 4 * g4 + rg);
#pragma unroll
            for (int c = 0; c < 8; ++c) { O[c][0] *= aO[0]; O[c][1] *= aO[1]; O[c][2] *= aO[2]; O[c][3] *= aO[3]; }
        }
        float ps = 0.f;
#pragma unroll
        for (int ks = 0; ks < 2; ++ks)
#pragma unroll
            for (int u = 0; u < 2; ++u)
#pragma unroll
                for (int rg = 0; rg < 4; ++rg) { const float pv = fast_exp(st[ks][u][rg] - m); st[ks][u][rg] = pv; ps += pv; }
        lsum += ps;
        bf16x8 pf[2];
#pragma unroll
        for (int ks = 0; ks < 2; ++ks) { u32x4 pw; pw.x = cvt_pk_bf16(st[ks][0][0], st[ks][0][1]); pw.y = cvt_pk_bf16(st[ks][0][2], st[ks][0][3]); pw.z = cvt_pk_bf16(st[ks][1][0], st[ks][1][1]); pw.w = cvt_pk_bf16(st[ks][1][2], st[ks][1][3]);
            pf[ks] = __builtin_bit_cast(bf16x8, pw); }
#pragma unroll
        for (int c = 0; c < 8; ++c)
#pragma unroll
            for (int ks = 0; ks < 2; ++ks) {
                const unsigned q = (unsigned)l15 >> 2, p = (unsigned)lane & 3u;
                const s16x4 v0 = ds_tr(buf + offb(32 * ks + 8 * g4 + 0 + q, 2 * c + (p >> 1)) + 8 * (p & 1));
                const s16x4 v1 = ds_tr(buf + offb(32 * ks + 8 * g4 + 4 + q, 2 * c + (p >> 1)) + 8 * (p & 1));
                const bf16x8 vb = (bf16x8){v0[0], v0[1], v0[2], v0[3], v1[0], v1[1], v1[2], v1[3]};
                O[c] = __builtin_amdgcn_mfma_f32_16x16x32_bf16(pf[ks], vb, O[c], 0, 0, 0);
            }
        asm volatile("s_waitcnt lgkmcnt(0)" ::: "memory");
    }
    const float lt = xsum4(lsum);
    float inv[4];
#pragma unroll
    for (int rg = 0; rg < 4; ++rg) inv[rg] = 1.0f / __shfl(lt, 4 * g4 + rg);
    if (g4 < 2 && !F.dry) {
#pragma unroll
        for (int rg = 0; rg < 4; ++rg)
#pragma unroll
            for (int c = 0; c < 8; ++c) qrow[(4 * g4 + rg) * 128 + 16 * c + l15] = (bf16_t)f2bf(O[c][rg] * inv[rg]);
    }
}
__device__ __forceinline__ void p3_sparse_attn(Frame& F) {
    LAS unsigned short* lut = (LAS unsigned short*)(F.lds + P3_LUT);
    for (int i = F.tid; i < 129 * 32; i += NWAVES * 64) lut[i] = (unsigned short)((t5_bucket(i >> 5) == (i & 31)) ? 0x3F80 : 0);
    bf16x8 bfrag;
    { const int l15 = F.lane & 15, g4 = F.lane >> 4; unsigned wv[4];
#pragma unroll
      for (int j = 0; j < 4; ++j) wv[j] = (l15 < 8) ? pk2(F.in[I_REL_BIAS][(8 * g4 + 2 * j) * 8 + l15], F.in[I_REL_BIAS][(8 * g4 + 2 * j + 1) * 8 + l15]) : 0u;
      bfrag = __builtin_bit_cast(bf16x8, (u32x4){wv[0], wv[1], wv[2], wv[3]}); }
    __syncthreads();
    if (F.G == 256) {
        const int x = F.vcu >> 5, wl = (F.vcu & 31) * 8 + F.wave;
        for (int i = 0; i < 16; ++i) { const int qi = wl + 256 * i; p3_query(F, x + 8 * (qi >> 11), qi & 2047, bfrag); }
    } else {
        for (int q = F.vcu * NWAVES + F.wave; q < NTOK; q += F.G * NWAVES) p3_query(F, q >> 11, q & 2047, bfrag);
    }
}

__device__ __forceinline__ void p4_issue(const bf16_t* A, int b, int h, int k0, LAS unsigned char* dst, int lane) {
#pragma unroll
    for (int g = 0; g < 4; ++g) { const int row = 8 * g + (lane >> 3), pos = lane & 7;
        const bf16_t* src = A + (size_t)(b * SEQ + k0 + row) * LDA + h * 64;
        __builtin_amdgcn_global_load_lds((const unsigned*)(src + CA_KB + 8 * (pos ^ ((row >> 1) & 7))), (LAS unsigned*)(dst + g * 1024), 16, 0, 0);
        __builtin_amdgcn_global_load_lds((const unsigned*)(src + CA_VB + 8 * (pos ^ (((row >> 1) & 1) << 2))), (LAS unsigned*)(dst + 4096 + g * 1024), 16, 0, 0); }
}
__device__ __forceinline__ void p4_unit(Frame& F, int b, int h, int qt) {
    const int lane = F.lane, w = F.wave, r = lane & 31, hh = lane >> 5;
    bf16_t* A = (bf16_t*)(F.ws + WS_A);
    LAS unsigned char* wbuf = F.lds + w * 16384;
    const int t0 = 32 * qt;
    bf16_t* qrow = A + (size_t)(b * SEQ + t0 + r) * LDA + CA_QB + h * 64;
    bf16x8 qf[4];
#pragma unroll
    for (int s = 0; s < 4; ++s) qf[s] = *(const bf16x8*)(qrow + 16 * s + 8 * hh);
    asm volatile("s_waitcnt vmcnt(0)" ::: "memory");
    f32x16 o0, o1;
#pragma unroll
    for (int i = 0; i < 16; ++i) { o0[i] = 0.f; o1[i] = 0.f; }
    float carry = 0.f;
    const unsigned q4 = (unsigned)(lane & 15) >> 2, p4 = (unsigned)lane & 3u, blk = (unsigned)(lane >> 4) & 1u;
    for (int kt = qt; kt >= 0; --kt) {
        LAS unsigned char* kb = wbuf; LAS unsigned char* vb = kb + 4096;
        asm volatile("s_waitcnt lgkmcnt(0)" ::: "memory");
        p4_issue(A, b, h, 32 * kt, wbuf, lane);
        asm volatile("s_waitcnt vmcnt(0)" ::: "memory");
        f32x16 z;
#pragma unroll
        for (int i = 0; i < 16; ++i) z[i] = 0.f;
#pragma unroll
        for (int s = 0; s < 4; ++s) { const bf16x8 kf = *(const LAS bf16x8*)(kb + r * 128 + 16 * ((2 * s + hh) ^ ((r >> 1) & 7))); z = __builtin_amdgcn_mfma_f32_32x32x16_bf16(kf, qf[s], z, 0, 0, 0); }
        const bool diag = (kt == qt);
        float L[16], lsg[16];
#pragma unroll
        for (int i = 0; i < 16; ++i) { const int key = (i & 3) + 8 * (i >> 2) + 4 * hh; const bool msk = diag && !(key < r);
            const float zz = z[i]; const float sp = fmaxf(zz, 0.f) + 0.69314718056f * __builtin_amdgcn_logf(1.0f + __builtin_amdgcn_exp2f(-fabsf(zz) * 1.44269504089f));
            L[i] = msk ? 0.f : -sp; lsg[i] = msk ? -__builtin_inff() : zz - sp; }
        float Gs[4], PG[4];
#pragma unroll
        for (int i4 = 0; i4 < 4; ++i4) { Gs[i4] = (L[4 * i4] + L[4 * i4 + 1]) + (L[4 * i4 + 2] + L[4 * i4 + 3]); PG[i4] = __shfl_xor(Gs[i4], 32); }
        float suf[4]; float run = 0.f;
#pragma unroll
        for (int i4 = 3; i4 >= 0; --i4) { suf[i4] = run + (hh == 0 ? PG[i4] : 0.f); run += Gs[i4] + PG[i4]; }
        float a[16];
#pragma unroll
        for (int i4 = 0; i4 < 4; ++i4) { float aft = carry + suf[i4];
#pragma unroll
            for (int rr = 3; rr >= 0; --rr) { const int i = 4 * i4 + rr; a[i] = fast_exp(lsg[i] + aft); aft += L[i]; } }
        carry += run;
        bf16x8 pb[2];
#pragma unroll
        for (int s = 0; s < 2; ++s) { u32x4 pw; pw.x = cvt_pk_bf16(a[8 * s], a[8 * s + 1]); pw.y = cvt_pk_bf16(a[8 * s + 2], a[8 * s + 3]); pw.z = cvt_pk_bf16(a[8 * s + 4], a[8 * s + 5]); pw.w = cvt_pk_bf16(a[8 * s + 6], a[8 * s + 7]);
            pb[s] = __builtin_bit_cast(bf16x8, pw); }
#pragma unroll
        for (int s = 0; s < 2; ++s) {
            const unsigned ra = 16 * s + 4 * hh + q4, rb = ra + 8;
            const unsigned ca = 2 * blk + (p4 >> 1), cb = 4 + ca, sa = ((ra >> 1) & 1u) << 2, sb = ((rb >> 1) & 1u) << 2;
            const s16x4 a0 = ds_tr(vb + ra * 128 + 16 * (ca ^ sa) + 8 * (p4 & 1));
            const s16x4 a1 = ds_tr(vb + rb * 128 + 16 * (ca ^ sb) + 8 * (p4 & 1));
            const s16x4 c0 = ds_tr(vb + ra * 128 + 16 * (cb ^ sa) + 8 * (p4 & 1));
            const s16x4 c1 = ds_tr(vb + rb * 128 + 16 * (cb ^ sb) + 8 * (p4 & 1));
            const bf16x8 va0 = (bf16x8){a0[0], a0[1], a0[2], a0[3], a1[0], a1[1], a1[2], a1[3]};
            const bf16x8 va1 = (bf16x8){c0[0], c0[1], c0[2], c0[3], c1[0], c1[1], c1[2], c1[3]};
            o0 = __builtin_amdgcn_mfma_f32_32x32x16_bf16(va0, pb[s], o0, 0, 0, 0);
            o1 = __builtin_amdgcn_mfma_f32_32x32x16_bf16(va1, pb[s], o1, 0, 0, 0);
        }
        if (__all(carry < -104.0f)) break;
    }
    asm volatile("s_waitcnt vmcnt(0)" ::: "memory");
    if (!F.dry)
#pragma unroll
    for (int i4 = 0; i4 < 4; ++i4) {
        u32x2 w0; w0.x = cvt_pk_bf16(o0[4 * i4], o0[4 * i4 + 1]); w0.y = cvt_pk_bf16(o0[4 * i4 + 2], o0[4 * i4 + 3]); *(u32x2*)(qrow + 8 * i4 + 4 * hh) = w0;
        u32x2 w1; w1.x = cvt_pk_bf16(o1[4 * i4], o1[4 * i4 + 1]); w1.y = cvt_pk_bf16(o1[4 * i4 + 2], o1[4 * i4 + 3]); *(u32x2*)(qrow + 32 + 8 * i4 + 4 * hh) = w1;
    }
}
__device__ __forceinline__ void p4_stickbreak(Frame& F) {
    if (F.G == 256) {
        const int x = F.vcu >> 5, wl = (F.vcu & 31) * 8 + F.wave, bh = wl >> 4, j = wl & 15;
        const int b = x + 8 * (bh >> 3), h = bh & 7;
        p4_unit(F, b, h, j); p4_unit(F, b, h, 63 - j); p4_unit(F, b, h, 16 + j); p4_unit(F, b, h, 47 - j);
    } else {
        for (int u = F.vcu * NWAVES + F.wave; u < NB * 8 * 64; u += F.G * NWAVES) p4_unit(F, u >> 9, (u >> 6) & 7, u & 63);
    }
}

constexpr int P8_LG = 0;
__device__ __forceinline__ void p8_router(Frame& F) {
    const int lane = F.lane, w = F.wave, l15 = lane & 15, g4 = lane >> 4;
    const bf16_t* X1b = (const bf16_t*)(F.ws + WS_A);
    const bf16_t* RH = (const bf16_t*)(F.ws + W_RHI); const bf16_t* RL = (const bf16_t*)(F.ws + W_RLO);
    int* perm = (int*)(F.ws + S_PERM); float* RSa = (float*)(F.ws + S_RS); float* CWa = (float*)(F.ws + S_CW); int* tokslot = (int*)(F.ws + S_TOKSLOT);
    unsigned* cnt = F.ctl + CW_CNT + (F.dry ? 4096 : 0);
    LAS float* lg = (LAS float*)(F.lds + P8_LG + w * 4096);
    LAS unsigned* lcnt = (LAS unsigned*)(F.lds + MISC_OFF + 8192);
    const int nround = (NTOK / 16 + F.G * NWAVES - 1) / (F.G * NWAVES);
    for (int rd = 0; rd < nround; ++rd) {
        const int grp0 = rd * F.G * NWAVES + F.vcu * NWAVES + w; const bool gvalid = grp0 < NTOK / 16; const int grp = gvalid ? grp0 : 0;
        __syncthreads();
        if (F.tid < 32) lcnt[F.tid] = 0u;
        __syncthreads();
        const int tok0 = grp * 16;
        const bf16_t* xr = X1b + (size_t)(tok0 + l15) * DM + 8 * g4;
        f32x4 acc[3];
#pragma unroll
        for (int j = 0; j < 3; ++j) acc[j] = (f32x4){0.f, 0.f, 0.f, 0.f};
        float ss = 0.f;
        LAS unsigned char* wl = F.lds + 32768;
#pragma unroll 1
        for (int half = 0; half < 2; ++half) {
            u32x4 xa[16];
#pragma unroll
            for (int ks = 0; ks < 16; ++ks) xa[ks] = *(const u32x4*)(xr + 512 * half + 32 * ks);
            __syncthreads();
            for (int idx = F.tid; idx < 72 * 64; idx += NWAVES * 64) { const int row = idx >> 6, c = idx & 63;
                const bf16_t* src = (row < 36 ? RH + (size_t)row * DM : RL + (size_t)(row - 36) * DM) + 512 * half + 8 * c;
                *(LAS u32x4*)(wl + row * 1040 + c * 16) = *(const u32x4*)src; }
            __syncthreads();
#pragma unroll
            for (int ks = 0; ks < 16; ++ks) {
                const u32x4 xw = xa[ks];
                { const float a0 = bflo(xw.x), a1 = bfhi(xw.x), a2 = bflo(xw.y), a3 = bfhi(xw.y), a4 = bflo(xw.z), a5 = bfhi(xw.z), a6 = bflo(xw.w), a7 = bfhi(xw.w);
                  ss += (a0 * a0 + a1 * a1) + (a2 * a2 + a3 * a3) + (a4 * a4 + a5 * a5) + (a6 * a6 + a7 * a7); }
                const bf16x8 ah = __builtin_bit_cast(bf16x8, xw);
#pragma unroll
                for (int j = 0; j < 3; ++j) {
                    const bf16x8 bh = *(const LAS bf16x8*)(wl + (16 * j + l15) * 1040 + 64 * ks + 16 * g4), bl = *(const LAS bf16x8*)(wl + (36 + 16 * j + l15) * 1040 + 64 * ks + 16 * g4);
                    acc[j] = __builtin_amdgcn_mfma_f32_16x16x32_bf16(ah, bh, acc[j], 0, 0, 0);
                    acc[j] = __builtin_amdgcn_mfma_f32_16x16x32_bf16(ah, bl, acc[j], 0, 0, 0);
                }
            }
        }
        ss += __shfl_xor(ss, 16); ss += __shfl_xor(ss, 32);
#pragma unroll
        for (int j = 0; j < 3; ++j)
#pragma unroll
            for (int rg = 0; rg < 4; ++rg) lg[(4 * g4 + rg) * 48 + 16 * j + l15] = acc[j][rg];
        asm volatile("s_waitcnt lgkmcnt(0)" ::: "memory");
        int E0 = 0, E1 = 0, r0 = 0, r1 = 0; float rstd = 0.f, cw0 = 0.f, cw1 = 0.f;
        const bool act = gvalid && lane < 16;
        if (act) {
            rstd = 1.0f / sqrtf(ss * (1.f / DM) + EPS);
            const LAS float* q = lg + lane * 48;
            float gl[4]; int gs = 0; float gmax;
#pragma unroll
            for (int g = 0; g < 4; ++g) gl[g] = q[g] * rstd + F.in[I_B_R1][g];
            gmax = gl[0];
#pragma unroll
            for (int g = 1; g < 4; ++g) if (gl[g] > gmax) { gmax = gl[g]; gs = g; }
            float den = 0.f;
#pragma unroll
            for (int g = 0; g < 4; ++g) den += __expf(gl[g] - gmax);
            const float pg = 1.0f / den;
            float el[8];
#pragma unroll
            for (int e = 0; e < 8; ++e) el[e] = q[4 + 8 * gs + e] * rstd + F.in[I_B_R2][gs * 8 + e];
            int i0 = 0; float v0 = el[0];
#pragma unroll
            for (int e = 1; e < 8; ++e) if (el[e] > v0) { v0 = el[e]; i0 = e; }
            int i1 = -1; float v1 = -__builtin_inff();
#pragma unroll
            for (int e = 0; e < 8; ++e) if (e != i0 && el[e] > v1) { v1 = el[e]; i1 = e; }
            const float w0 = 1.0f / (1.0f + __expf(v1 - v0));
            cw0 = w0 * pg; cw1 = (1.0f - w0) * pg;
            E0 = gs * 8 + i0; E1 = gs * 8 + i1;
            r0 = (int)__hip_atomic_fetch_add(lcnt + E0, 1u, __ATOMIC_RELAXED, __HIP_MEMORY_SCOPE_WORKGROUP);
            r1 = (int)__hip_atomic_fetch_add(lcnt + E1, 1u, __ATOMIC_RELAXED, __HIP_MEMORY_SCOPE_WORKGROUP);
        }
        __syncthreads();
        if (F.tid < 32) { const unsigned c = lcnt[F.tid]; lcnt[32 + F.tid] = c ? __hip_atomic_fetch_add(cnt + 64 * F.tid, c, __ATOMIC_RELAXED, __HIP_MEMORY_SCOPE_AGENT) : 0u; }
        __syncthreads();
        if (act && !F.dry) {
            const int tok = tok0 + lane; const int p0 = (int)lcnt[32 + E0] + r0, p1 = (int)lcnt[32 + E1] + r1;
            perm[(size_t)E0 * ECAP + p0] = tok; RSa[(size_t)E0 * ECAP + p0] = rstd; CWa[(size_t)E0 * ECAP + p0] = cw0;
            perm[(size_t)E1 * ECAP + p1] = tok; RSa[(size_t)E1 * ECAP + p1] = rstd; CWa[(size_t)E1 * ECAP + p1] = cw1;
            tokslot[2 * tok] = (E0 << 16) | p0; tokslot[2 * tok + 1] = (E1 << 16) | p1;
        }
        asm volatile("s_waitcnt lgkmcnt(0)" ::: "memory");
    }
}

constexpr int MOE_TB = MISC_OFF + 8192;
__device__ __forceinline__ void moe_tables(Frame& F) {
    LAS int* tb = (LAS int*)(F.lds + MOE_TB);
    __syncthreads();
    if (F.tid < 32) tb[64 + F.tid] = (int)F.ctl[CW_CNT + 64 * F.tid];
    __syncthreads();
    if (F.tid == 0) { int s = 0; for (int e = 0; e < 32; ++e) { tb[e] = s; s += (tb[64 + e] + 255) >> 8; } tb[32] = s; }
    __syncthreads();
}
struct MoeOrder {
    const LAS int* tb; const int* perm; int npn, G, c;
    __device__ __forceinline__ bool next(int i, pg8::Unit& u) const {
        const int U = tb[32] * npn; int L;
        if ((G & 7) == 0) { const int x = c & 7, j = c >> 3, per = G >> 3, q = U >> 3, r = U & 7; const int start = x * q + (x < r ? x : r), len = q + (x < r ? 1 : 0); const int li = j + per * i; if (li >= len) return false; L = start + li; }
        else { L = i * G + c; if (L >= U) return false; }
        const int tau = L / npn, pn = L % npn; int e = 0;
        for (int k = 1; k < 32; ++k) if (tb[k] <= tau) e = k;
        u.pm = __builtin_amdgcn_readfirstlane(tau); u.pn = __builtin_amdgcn_readfirstlane(pn); u.e = __builtin_amdgcn_readfirstlane(e); u.pb = u.e * npn + u.pn;
        u.r0 = __builtin_amdgcn_readfirstlane((tau - tb[e]) * 256); u.ne = __builtin_amdgcn_readfirstlane(tb[64 + e]); return true;
    }
    __device__ __forceinline__ int arow(const pg8::Unit& u, int r) const { const int pos = u.r0 + r; return perm[(size_t)u.e * ECAP + (pos < u.ne ? pos : 0)]; }
};

#ifndef T1_IN_P1
#define T1_IN_P1 32
#endif
struct PleFillOrder {
    int G, c, hx, off, cnt;
    __device__ __forceinline__ bool next(int i, pg8::Unit& u) const {
        int L;
        if ((G & 7) == 0) { const int x = c & 7, j = c >> 3, per = G >> 3;
            if (j < hx) return false;
            const int li = (j - hx) + (per - hx) * i; if (li >= cnt) return false; L = x * 64 + off + li; }
        else { if (off != 0) return false; L = i * G + c; if (L >= 512) return false; }
        u.pm = __builtin_amdgcn_readfirstlane(L >> 2); u.pn = __builtin_amdgcn_readfirstlane(L & 3); u.pb = u.pn; u.e = 0; u.r0 = 0; u.ne = 0; return true;
    }
    __device__ __forceinline__ int arow(const pg8::Unit& u, int r) const { return u.pm * pg8::BM + r; }
};

__device__ __forceinline__ void p11_combine(Frame& F) {
    const int lane = F.lane; const LAS int* tb = (const LAS int*)(F.lds + MOE_TB);
    bf16_t* XB = (bf16_t*)(F.ws + WS_A); const bf16_t* Y = (const bf16_t*)(F.ws + WS_Y); const int* tokslot = (const int*)(F.ws + S_TOKSLOT);
    float* R3 = (float*)(F.ws + S_RSTD3);
    const int NGW = F.G * NWAVES;
    for (int m0 = F.vcu * NWAVES + F.wave; m0 < NTOK; m0 += 2 * NGW) {
        u32x4 xv[2][2], ya[2][2], yb[2][2];
#pragma unroll
        for (int u = 0; u < 2; ++u) { const int m = (m0 + u * NGW < NTOK) ? m0 + u * NGW : m0;
            const int s0 = tokslot[2 * m], s1 = tokslot[2 * m + 1];
            const size_t r0 = (size_t)tb[s0 >> 16] * 256 + (s0 & 0xffff), r1 = (size_t)tb[s1 >> 16] * 256 + (s1 & 0xffff);
            const u32x4* xr = (const u32x4*)(XB + (size_t)m * DM) + lane; const u32x4* y0 = (const u32x4*)(Y + r0 * DM) + lane; const u32x4* y1 = (const u32x4*)(Y + r1 * DM) + lane;
#pragma unroll
            for (int j = 0; j < 2; ++j) { xv[u][j] = xr[64 * j]; ya[u][j] = y0[64 * j]; yb[u][j] = y1[64 * j]; } }
#pragma unroll
        for (int u = 0; u < 2; ++u) { const int m = m0 + u * NGW; if (m < NTOK) {
            u32x4* xo = (u32x4*)(XB + (size_t)m * DM) + lane;
            float s = 0.f;
#pragma unroll
            for (int j = 0; j < 2; ++j) { const unsigned xw[4] = {xv[u][j].x, xv[u][j].y, xv[u][j].z, xv[u][j].w}, aw[4] = {ya[u][j].x, ya[u][j].y, ya[u][j].z, ya[u][j].w}, bw[4] = {yb[u][j].x, yb[u][j].y, yb[u][j].z, yb[u][j].w};
                unsigned ow[4];
#pragma unroll
                for (int q = 0; q < 4; ++q) { const float lo = bflo(xw[q]) + bflo(aw[q]) + bflo(bw[q]), hi = bfhi(xw[q]) + bfhi(aw[q]) + bfhi(bw[q]); s += lo * lo + hi * hi; ow[q] = pk2(lo, hi); }
                xo[64 * j] = (u32x4){ow[0], ow[1], ow[2], ow[3]}; }
            s = wave_sum(s);
            if (lane == 0) R3[m] = 1.0f / sqrtf(s * (1.f / DM) + EPS); } }
    }
}
__device__ __forceinline__ void p14_final(Frame& F) {
    const int lane = F.lane;
    f32x4 gn[4];
#pragma unroll
    for (int j = 0; j < 4; ++j) gn[j] = *(const f32x4*)(F.in[I_FINAL_NORM] + 4 * lane + 256 * j);
    const int NGW = F.G * NWAVES;
    for (int m0 = F.vcu * NWAVES + F.wave; m0 < NTOK; m0 += 2 * NGW) {
        f32x4 v[2][4];
#pragma unroll
        for (int u = 0; u < 2; ++u) { const int m = (m0 + u * NGW < NTOK) ? m0 + u * NGW : m0; const f32x4* xr = (const f32x4*)(F.out + (size_t)m * DM) + lane;
#pragma unroll
            for (int j = 0; j < 4; ++j) v[u][j] = xr[64 * j]; }
#pragma unroll
        for (int u = 0; u < 2; ++u) { const int m = m0 + u * NGW; if (m < NTOK) { f32x4* xr = (f32x4*)(F.out + (size_t)m * DM) + lane; float s = 0.f;
#pragma unroll
            for (int j = 0; j < 4; ++j) s += (v[u][j][0] * v[u][j][0] + v[u][j][1] * v[u][j][1]) + (v[u][j][2] * v[u][j][2] + v[u][j][3] * v[u][j][3]);
            const float rstd = 1.0f / sqrtf(wave_sum(s) * (1.f / DM) + EPS);
#pragma unroll
            for (int j = 0; j < 4; ++j) if (!F.dry) xr[64 * j] = v[u][j] * rstd * gn[j]; } }
    }
}

#ifndef MK_PER_PHASE
#define MK_PER_PHASE 0
#endif
constexpr int NPHASE = 14;
struct Args { const float* in[23]; float* out; unsigned char* ws; int ph_lo, ph_hi, dry, pad; };
__global__ void __launch_bounds__(NWAVES * 64, 2) fwd(Args args) {
    extern __shared__ __attribute__((aligned(16))) unsigned char lds[];
    Frame F;
    F.lds = (LAS unsigned char*)lds;
    F.tid = threadIdx.x; F.lane = F.tid & 63; F.wave = __builtin_amdgcn_readfirstlane(F.tid >> 6);
    F.G = gridDim.x; { const int bx = blockIdx.x; F.vcu = (F.G % 8 == 0) ? (bx % 8) * (F.G / 8) + bx / 8 : bx; }
    F.ws = args.ws; F.ctl = (unsigned*)(args.ws + WS_CTL); F.out = args.out; F.dry = 0;
#pragma unroll
    for (int i = 0; i < 23; ++i) F.in[i] = args.in[i];
    volatile LAS unsigned* MISC = (volatile LAS unsigned*)(F.lds + MISC_OFF);
    if (F.tid < 16) MISC[F.tid] = 0u;
    __syncthreads();
    XcdBarrier bar; bar.bar = F.ctl + CW_BAR; bar.x = 0; bar.st = MISC;
    if (!MK_PER_PHASE) bar = xcd_barrier_post(F.ctl + CW_BAR, MISC);
    const int lo = args.ph_lo, hi = args.ph_hi;
#ifndef PH_MASK
#define PH_MASK 0x7fff
#endif
#define IN(k) (((PH_MASK >> (k)) & 1) && lo <= (k) && (k) < hi)
#define SEAM(k) do { if (IN((k) + 1)) xcd_barrier(bar); } while (0)
#ifdef PROBE_PH
#define PROBE(k, body) do { if (PROBE_PH == (k)) { F.dry = args.dry; body; xcd_barrier(bar); F.dry = 0; } } while (0)
#else
#define PROBE(k, body) do { } while (0)
#endif
    unsigned char* ws = args.ws;
    const int bx = (int)blockIdx.x;
    LAS unsigned char* ring = F.lds;

    if (IN(0)) { PROBE(0, p0_prologue(F)); p0_prologue(F); SEAM(0); }
    if (IN(1)) {
        pg8::Gemm g{(const bf16_t*)(ws + WS_H), (const bf16_t*)(ws + W_IN), DM, DM}; pg8::StaticOrder S; S.init(NTOK, NPROJ, F.G, bx);
        pg8::EpiProj E{(bf16_t*)(ws + WS_A), (bf16_t*)(ws + WS_G), ws + S_KIDX};
        PROBE(1, (pg8::gemm_phase<pg8::EpiProj, pg8::StaticOrder, false>(ring, g, S, E)));
        pg8::gemm_phase<pg8::EpiProj, pg8::StaticOrder, false>(ring, g, S, E);
        {
            int hx = 0;
            if ((F.G & 7) == 0) { const int per = F.G >> 3, len = S.nwg >> 3; hx = len % per; }
            pg8::Gemm g2{(const bf16_t*)(ws + WS_PB), (const bf16_t*)(ws + W_PLE), 256, 256};
            PleFillOrder S2{F.G, bx, hx, 0, (F.G & 7) ? 64 : T1_IN_P1};
            pg8::EpiBf16 E2{(bf16_t*)F.out + 256, 2 * DM, 512};
            pg8::gemm_phase<pg8::EpiBf16, PleFillOrder, false>(ring, g2, S2, E2); }
        SEAM(1); }
    if (IN(2)) { p1b_extract(F); }
    if (IN(3)) { PROBE(3, p2_indexer(F)); p2_indexer(F); SEAM(3); }
    if (IN(4)) { PROBE(4, p3_sparse_attn(F)); PROBE(15, p4_stickbreak(F)); p3_sparse_attn(F); __syncthreads(); p0b_late_weights(F); __syncthreads(); p4_stickbreak(F); SEAM(4); }
    if (IN(5)) {
        pg8::Gemm g{(const bf16_t*)(ws + WS_A) + CA_QABS, (const bf16_t*)(ws + W_COMB), LDA, DM}; pg8::StaticOrder S; S.init(NTOK, DM, F.G, bx);
        pg8::EpiGate<false> E{(const bf16_t*)(ws + WS_G), 0, (bf16_t*)(ws + WS_H)};
        PROBE(5, (pg8::gemm_phase<pg8::EpiGate<false>, pg8::StaticOrder, false>(ring, g, S, E)));
        pg8::gemm_phase<pg8::EpiGate<false>, pg8::StaticOrder, false>(ring, g, S, E); }
    if (IN(6)) {
        pg8::Gemm g{(const bf16_t*)(ws + WS_A) + CA_QB, (const bf16_t*)(ws + W_BB), LDA, 512}; pg8::StaticOrder S; S.init(NTOK, DM, F.G, bx);
        pg8::EpiGate<true> E{(const bf16_t*)(ws + WS_G), 1024, (bf16_t*)(ws + WS_H)};
        pg8::gemm_phase<pg8::EpiGate<true>, pg8::StaticOrder, false>(ring, g, S, E); SEAM(6); }
    if (IN(7)) {
        pg8::Gemm g{(const bf16_t*)(ws + WS_H), (const bf16_t*)(ws + W_OUT), DM, DM}; pg8::StaticOrder S; S.init(NTOK, DM, F.G, bx);
        pg8::EpiResid E{F.in[I_X], (bf16_t*)(ws + WS_A)};
        PROBE(7, (pg8::gemm_phase<pg8::EpiResid, pg8::StaticOrder, false>(ring, g, S, E)));
        pg8::gemm_phase<pg8::EpiResid, pg8::StaticOrder, false>(ring, g, S, E); SEAM(7); }
    if (IN(8)) { PROBE(8, p8_router(F)); p8_router(F); SEAM(8); }
    if (IN(9)) {
        moe_tables(F);
        pg8::Gemm g{(const bf16_t*)(ws + WS_A), (const bf16_t*)(ws + W_GU), DM, DM};
        MoeOrder S{(const LAS int*)(F.lds + MOE_TB), (const int*)(ws + S_PERM), 2, F.G, bx};
        pg8::EpiMoeUp E{(const float*)(ws + S_RS), (const float*)(ws + S_CW), (bf16_t*)(ws + WS_H)};
        PROBE(9, (pg8::gemm_phase<pg8::EpiMoeUp, MoeOrder, true>(ring, g, S, E)));
        pg8::gemm_phase<pg8::EpiMoeUp, MoeOrder, true>(ring, g, S, E);
        {
            const LAS int* tb = (const LAS int*)(F.lds + MOE_TB); int hx = 0;
            if ((F.G & 7) == 0) { const int x = bx & 7, per = F.G >> 3, U = tb[32] * 2, q = U >> 3, r = U & 7, len = q + (x < r ? 1 : 0); hx = len - 2 * per; hx = hx < 0 ? 0 : (hx > per - 1 ? per - 1 : hx); }
            pg8::Gemm g2{(const bf16_t*)(ws + WS_PB), (const bf16_t*)(ws + W_PLE), 256, 256};
            PleFillOrder S2{F.G, bx, hx, T1_IN_P1, (F.G & 7) ? 0 : 64 - T1_IN_P1};
            pg8::EpiBf16 E2{(bf16_t*)F.out + 256, 2 * DM, 512};
            pg8::gemm_phase<pg8::EpiBf16, PleFillOrder, false>(ring, g2, S2, E2); }
        SEAM(9); }
    if (IN(10)) {
        moe_tables(F);
        pg8::Gemm g{(const bf16_t*)(ws + WS_H), (const bf16_t*)(ws + W_DN), DEXP, DEXP};
        MoeOrder S{(const LAS int*)(F.lds + MOE_TB), (const int*)(ws + S_PERM), 4, F.G, bx};
        pg8::EpiBf16 E{(bf16_t*)(ws + WS_Y), DM, 256};
        PROBE(10, (pg8::gemm_phase<pg8::EpiBf16, MoeOrder, false>(ring, g, S, E)));
        pg8::gemm_phase<pg8::EpiBf16, MoeOrder, false>(ring, g, S, E); SEAM(10); }
    if (IN(11)) { moe_tables(F); PROBE(11, p11_combine(F)); p11_combine(F); SEAM(11); }
    if (IN(13)) {
        pg8::Gemm g{(const bf16_t*)(ws + WS_A), (const bf16_t*)(ws + W_PG), DM, DM}; pg8::StaticOrder S; S.init(NTOK, DM, F.G, bx);
        pg8::EpiPleFinal E{F.out, (const bf16_t*)(ws + WS_A), (const bf16_t*)F.out + 256, (const float*)(ws + S_RSTD3), F.in[I_FINAL_NORM], (float*)(ws + S_PART), F.ctl + CW_PANEL, (LAS float*)(F.lds + MISC_OFF + 8192)};
        pg8::gemm_phase<pg8::EpiPleFinal, pg8::StaticOrder, false>(ring, g, S, E); }
#undef IN
#undef SEAM
}

extern "C" void kernel_launch(void* const* d_in, const int* in_sizes, int n_in, void* d_out, int out_size, void* d_ws, size_t ws_size, hipStream_t stream) {
    static int grid = 0;
    if (grid == 0) {
        if (n_in != 23 || out_size != NTOK * DM || ws_size < WS_END) { fprintf(stderr, "kernel_launch: unexpected shapes (n_in %d out %d ws %zu)\n", n_in, out_size, ws_size); grid = -1; return; }
        int dev = 0, cus = 0, per_cu = 0;
        if (hipGetDevice(&dev) != hipSuccess || hipDeviceGetAttribute(&cus, hipDeviceAttributeMultiprocessorCount, dev) != hipSuccess) { grid = -1; return; }
        if (hipFuncSetAttribute((const void*)fwd, hipFuncAttributeMaxDynamicSharedMemorySize, LDS_BYTES) != hipSuccess) { fprintf(stderr, "kernel_launch: hipFuncSetAttribute failed\n"); grid = -1; return; }
        if (hipOccupancyMaxActiveBlocksPerMultiprocessor(&per_cu, (const void*)fwd, NWAVES * 64, LDS_BYTES) != hipSuccess || per_cu < 1) fprintf(stderr, "kernel_launch: occupancy query says %d\n", per_cu);
        (void)hipGetLastError();
        grid = cus;
    }
    if (grid < 0) return;
    (void)hipMemsetAsync((char*)d_ws + WS_CTL, 0, CTL_ZERO_BYTES, stream);
    Args a{};
    for (int i = 0; i < 23; ++i) a.in[i] = (const float*)d_in[i];
    a.out = (float*)d_out; a.ws = (unsigned char*)d_ws; a.dry = 1;
#if MK_PER_PHASE
    for (int p = 0; p < NPHASE; ++p) { a.ph_lo = p; a.ph_hi = p + 1; hipLaunchKernelGGL(fwd, dim3(grid), dim3(NWAVES * 64), LDS_BYTES, stream, a); }
#else
    a.ph_lo = 0; a.ph_hi = NPHASE; hipLaunchKernelGGL(fwd, dim3(grid), dim3(NWAVES * 64), LDS_BYTES, stream, a);
#endif
}
```
